# Optimizing an MI355X kernel written in HIP

```python
import jax
import jax.numpy as jnp
from jax import lax
import numpy as np

D_MODEL = 2048
BATCH = 8
SEQ = 2048
DEPTH = 2

HEAD_DIM = 64
GRID_W = 64
Q_BLOCK = 128
ROPE_THETA = 10000.0
NEG_INF = -1e30
EPS = 1e-6
N_BRANCH = 4
BRANCH_WIDTH = 512

A_HEADS = 8
A_DILATIONS = ((128, 1), (512, 4), (2048, 16))
N_DIL = 3
MLA_HEADS = 8
MLA_Q_LORA = 512
MLA_KV_LORA = 256
MLA_NOPE = 64
MLA_ROPE = 32
MLA_V = 64
C_Q_HEADS = 8
C_KV_HEADS = 2
D_Q_HEADS = 8
D_KV_HEADS = 2
D_HALF_WINDOW = 128

A_COLS = 3 * N_DIL * A_HEADS * HEAD_DIM
B_COLS = MLA_Q_LORA + MLA_KV_LORA + MLA_ROPE
C_COLS = (C_Q_HEADS + 2 * C_KV_HEADS) * HEAD_DIM
D_COLS = (D_Q_HEADS + 2 * D_KV_HEADS) * HEAD_DIM
GATE_COLS = N_BRANCH * D_MODEL
IN_SPLITS = (A_COLS, A_COLS + B_COLS, A_COLS + B_COLS + C_COLS, A_COLS + B_COLS + C_COLS + D_COLS)
N_IN = A_COLS + B_COLS + C_COLS + D_COLS + GATE_COLS

N_EXPERTS = 16
EXPERT_FF = D_MODEL // 2
CAPACITY_FACTOR = 2

kernel_name = 'hybrid_gated_mixer_ec_moe_encoder'


def rms_norm(x, g):
    xf = x.astype(jnp.float32)
    y = xf * lax.rsqrt(jnp.mean(xf * xf, axis=-1, keepdims=True) + EPS)
    return (y * g.astype(jnp.float32)).astype(x.dtype)


def alibi_slopes(n):
    return jnp.exp2(-8.0 * jnp.arange(1, n + 1, dtype=jnp.float32) / n)


def rope(x, pos):
    dim = x.shape[-1]
    freqs = ROPE_THETA ** (-jnp.arange(0, dim, 2, dtype=jnp.float32) / dim)
    ang = pos.astype(jnp.float32)[:, None] * freqs[None, :]
    cos = jnp.cos(ang)[None, :, None, :]
    sin = jnp.sin(ang)[None, :, None, :]
    xf = x.astype(jnp.float32)
    x1, x2 = xf[..., : dim // 2], xf[..., dim // 2:]
    return jnp.concatenate([x1 * cos - x2 * sin, x1 * sin + x2 * cos], axis=-1).astype(x.dtype)


def axial_rope(x, rows, cols):
    half = x.shape[-1] // 2
    return jnp.concatenate([rope(x[..., :half], rows), rope(x[..., half:], cols)], axis=-1)


def banded_attention(q, k, v, half_window, slopes, sink=None):
    Z, L, H, G, dh = q.shape
    W = half_window
    nb = -(-L // W)
    Lp = nb * W
    pad = Lp - L
    qb = jnp.pad(q, ((0, 0), (0, pad), (0, 0), (0, 0), (0, 0))).reshape(Z, nb, W, H, G, dh)
    kp = jnp.pad(k, ((0, 0), (W, pad + W), (0, 0), (0, 0)))
    vp = jnp.pad(v.astype(jnp.float32), ((0, 0), (W, pad + W), (0, 0), (0, 0)))

    def key_blocks(a):
        return jnp.concatenate([a[:, i * W: i * W + Lp].reshape(Z, nb, W, H, a.shape[-1]) for i in range(3)], axis=2)

    kb, vb = key_blocks(kp), key_blocks(vp)
    qpos = jnp.arange(nb)[:, None] * W + jnp.arange(W)[None, :]
    kpos = jnp.arange(nb)[:, None] * W - W + jnp.arange(3 * W)[None, :]
    rel = kpos[:, None, :] - qpos[:, :, None]
    valid = (jnp.abs(rel) <= W) & (kpos[:, None, :] >= 0) & (kpos[:, None, :] < L)
    dist = jnp.abs(rel).astype(jnp.float32)
    s = jnp.einsum('znqhgd,znkhd->znhgqk', qb, kb).astype(jnp.float32) * (dh ** -0.5)
    s = s - slopes[None, None, :, :, None, None] * dist[None, :, None, None, :, :]
    s = jnp.where(valid[None, :, None, None, :, :], s, NEG_INF)
    m = jnp.max(s, axis=-1)
    if sink is not None:
        sk = sink.astype(jnp.float32)[None, None, :, :, None]
        m = jnp.maximum(m, sk)
    p = jnp.exp(s - m[..., None])
    den = jnp.sum(p, axis=-1)
    if sink is not None:
        den = den + jnp.exp(sk - m)
    o = jnp.einsum('znhgqk,znkhe->znqhge', p, vb) / jnp.transpose(den, (0, 1, 4, 2, 3))[..., None]
    lse = jnp.transpose(m + jnp.log(den), (0, 1, 4, 2, 3))
    o = o.reshape(Z, Lp, H, G, v.shape[-1])[:, :L]
    lse = lse.reshape(Z, Lp, H, G)[:, :L]
    return o.astype(q.dtype), lse


def dense_attention(q, k, v, scale):
    B, S, H, G, dq = q.shape
    nq = S // Q_BLOCK
    qb = jnp.moveaxis(q.reshape(B, nq, Q_BLOCK, H, G, dq), 1, 0)
    vf = v.astype(jnp.float32)

    def block(qi):
        s = jnp.einsum('bqhgd,bkhd->bhgqk', qi, k).astype(jnp.float32) * scale
        p = jax.nn.softmax(s, axis=-1)
        return jnp.einsum('bhgqk,bkhe->bqhge', p, vf).astype(q.dtype)

    out = lax.map(block, qb)
    return jnp.moveaxis(out, 0, 1).reshape(B, S, H, G, v.shape[-1])


def dilated_attention(q, k, v):
    B, S = q.shape[:2]
    slopes = alibi_slopes(A_HEADS)
    outs, lses = [], []
    for g, (window, dil) in enumerate(A_DILATIONS):
        half = (window // 2) // dil
        Ld = S // dil

        def fold(a):
            return jnp.transpose(a[:, :, g].reshape(B, Ld, dil, A_HEADS, HEAD_DIM), (0, 2, 1, 3, 4)).reshape(B * dil, Ld, A_HEADS, HEAD_DIM)

        o, lse = banded_attention(fold(q)[:, :, :, None, :], fold(k), fold(v), half, (slopes * dil)[:, None])
        o = jnp.transpose(o[:, :, :, 0].reshape(B, dil, Ld, A_HEADS, HEAD_DIM), (0, 2, 1, 3, 4)).reshape(B, S, A_HEADS, HEAD_DIM)
        lse = jnp.transpose(lse[:, :, :, 0].reshape(B, dil, Ld, A_HEADS), (0, 2, 1, 3)).reshape(B, S, A_HEADS)
        outs.append(o)
        lses.append(lse)
    w = jax.nn.softmax(jnp.stack(lses), axis=0)
    o = jnp.einsum('nbsh,nbshd->bshd', w, jnp.stack(outs).astype(jnp.float32))
    return o.reshape(B, S, A_HEADS * HEAD_DIM).astype(q.dtype)


def token_mixer(xn, w_in, b_gate, g_mla_q, g_mla_kv, w_mla_uq, w_mla_ukv, g_c_q, g_c_k, sink_d, w_branch, w_out):
    B, S, D = xn.shape
    rows_count = S // GRID_W
    pos = jnp.arange(S)
    rows = jnp.repeat(jnp.arange(rows_count), GRID_W)
    cols = jnp.tile(jnp.arange(GRID_W), rows_count)

    proj = xn @ w_in
    pa, pb, pc, pd, pg = jnp.split(proj, IN_SPLITS, axis=-1)

    pa = pa.reshape(B, S, 3, N_DIL, A_HEADS, HEAD_DIM)
    o_a = dilated_attention(pa[:, :, 0], pa[:, :, 1], pa[:, :, 2])

    c_q, c_kv, k_pe = jnp.split(pb, (MLA_Q_LORA, MLA_Q_LORA + MLA_KV_LORA), axis=-1)
    q_b = (rms_norm(c_q, g_mla_q) @ w_mla_uq).reshape(B, S, MLA_HEADS, MLA_NOPE + MLA_ROPE)
    q_b = jnp.concatenate([q_b[..., :MLA_NOPE], rope(q_b[..., MLA_NOPE:], pos)], axis=-1)
    kv_b = (rms_norm(c_kv, g_mla_kv) @ w_mla_ukv).reshape(B, S, MLA_HEADS, MLA_NOPE + MLA_V)
    k_pe = jnp.broadcast_to(rope(k_pe[:, :, None, :], pos), (B, S, MLA_HEADS, MLA_ROPE))
    k_b = jnp.concatenate([kv_b[..., :MLA_NOPE], k_pe], axis=-1)
    v_b = kv_b[..., MLA_NOPE:]
    o_b = dense_attention(q_b[:, :, :, None, :], k_b, v_b, (MLA_NOPE + MLA_ROPE) ** -0.5).reshape(B, S, MLA_HEADS * MLA_V)

    pc = pc.reshape(B, S, C_Q_HEADS + 2 * C_KV_HEADS, HEAD_DIM)
    q_c = axial_rope(rms_norm(pc[:, :, :C_Q_HEADS], g_c_q), rows, cols)
    k_c = axial_rope(rms_norm(pc[:, :, C_Q_HEADS:C_Q_HEADS + C_KV_HEADS], g_c_k), rows, cols)
    v_c = pc[:, :, C_Q_HEADS + C_KV_HEADS:]
    q_c = q_c.reshape(B, S, C_KV_HEADS, C_Q_HEADS // C_KV_HEADS, HEAD_DIM)
    o_c = dense_attention(q_c, k_c, v_c, HEAD_DIM ** -0.5).reshape(B, S, C_Q_HEADS * HEAD_DIM)

    pd = pd.reshape(B, S, D_Q_HEADS + 2 * D_KV_HEADS, HEAD_DIM)
    grp = D_Q_HEADS // D_KV_HEADS
    q_d = pd[:, :, :D_Q_HEADS].reshape(B, S, D_KV_HEADS, grp, HEAD_DIM)
    k_d = pd[:, :, D_Q_HEADS:D_Q_HEADS + D_KV_HEADS]
    v_d = pd[:, :, D_Q_HEADS + D_KV_HEADS:]
    o_d, _ = banded_attention(q_d, k_d, v_d, D_HALF_WINDOW, alibi_slopes(D_Q_HEADS).reshape(D_KV_HEADS, grp), sink_d.reshape(D_KV_HEADS, grp))
    o_d = o_d.reshape(B, S, D_Q_HEADS * HEAD_DIM)

    mixed = jnp.zeros((B, S, D), xn.dtype)
    for i, o in enumerate((o_a, o_b, o_c, o_d)):
        gate = jax.nn.sigmoid(pg[..., i * D:(i + 1) * D] + b_gate[i])
        mixed = mixed + gate * (o @ w_branch[i])
    return mixed @ w_out


def expert_choice_ffn(xn, w_router, w_gate, w_up, w_down):
    B, S, D = xn.shape
    cap = CAPACITY_FACTOR * S // N_EXPERTS
    probs = jax.nn.softmax((xn @ w_router).astype(jnp.float32), axis=-1)
    gate, idx = lax.top_k(jnp.transpose(probs, (0, 2, 1)), cap)
    xe = jax.vmap(lambda xb, ib: xb[ib])(xn, idx)
    h = jax.nn.silu(jnp.einsum('becd,edf->becf', xe, w_gate)) * jnp.einsum('becd,edf->becf', xe, w_up)
    ye = jnp.einsum('becf,efd->becd', h, w_down) * gate[..., None].astype(xn.dtype)
    return jax.vmap(lambda yb, ib: jax.ops.segment_sum(yb.reshape(-1, D), ib.reshape(-1), num_segments=S))(ye, idx)


def setup_inputs(seed: int = 0) -> dict:
    key = jax.random.key(seed)
    ks = jax.random.split(key, 20)
    f32 = jnp.float32

    def nrm(k, shape, scale):
        return jax.random.normal(k, shape, f32) * scale

    return {
        'x': nrm(ks[0], (BATCH, SEQ, D_MODEL), 1.0),
        'w_in': nrm(ks[1], (DEPTH, D_MODEL, N_IN), D_MODEL ** -0.5),
        'b_gate': nrm(ks[2], (DEPTH, N_BRANCH, D_MODEL), 0.02),
        'g_attn_norm': 1.0 + nrm(ks[3], (DEPTH, D_MODEL), 0.02),
        'g_ffn_norm': 1.0 + nrm(ks[4], (DEPTH, D_MODEL), 0.02),
        'g_mla_q': 1.0 + nrm(ks[5], (DEPTH, MLA_Q_LORA), 0.02),
        'g_mla_kv': 1.0 + nrm(ks[6], (DEPTH, MLA_KV_LORA), 0.02),
        'w_mla_uq': nrm(ks[7], (DEPTH, MLA_Q_LORA, MLA_HEADS * (MLA_NOPE + MLA_ROPE)), MLA_Q_LORA ** -0.5),
        'w_mla_ukv': nrm(ks[8], (DEPTH, MLA_KV_LORA, MLA_HEADS * (MLA_NOPE + MLA_V)), MLA_KV_LORA ** -0.5),
        'g_c_q': 1.0 + nrm(ks[9], (DEPTH, HEAD_DIM), 0.02),
        'g_c_k': 1.0 + nrm(ks[10], (DEPTH, HEAD_DIM), 0.02),
        'sink_d': nrm(ks[11], (DEPTH, D_Q_HEADS), 0.5),
        'w_branch': nrm(ks[12], (DEPTH, N_BRANCH, BRANCH_WIDTH, D_MODEL), BRANCH_WIDTH ** -0.5),
        'w_out': nrm(ks[13], (DEPTH, D_MODEL, D_MODEL), D_MODEL ** -0.5),
        'w_router': nrm(ks[14], (DEPTH, D_MODEL, N_EXPERTS), D_MODEL ** -0.5),
        'w_exp_gate': nrm(ks[15], (DEPTH, N_EXPERTS, D_MODEL, EXPERT_FF), D_MODEL ** -0.5),
        'w_exp_up': nrm(ks[16], (DEPTH, N_EXPERTS, D_MODEL, EXPERT_FF), D_MODEL ** -0.5),
        'w_exp_down': nrm(ks[17], (DEPTH, N_EXPERTS, EXPERT_FF, D_MODEL), EXPERT_FF ** -0.5),
        'g_final': 1.0 + nrm(ks[18], (D_MODEL,), 0.02),
    }


def reference(x, w_in, b_gate, g_attn_norm, g_ffn_norm, g_mla_q, g_mla_kv, w_mla_uq, w_mla_ukv, g_c_q, g_c_k, sink_d, w_branch, w_out, w_router, w_exp_gate, w_exp_up, w_exp_down, g_final):
    h = x
    for l in range(DEPTH):
        h = h + token_mixer(rms_norm(h, g_attn_norm[l]), w_in[l], b_gate[l], g_mla_q[l], g_mla_kv[l], w_mla_uq[l], w_mla_ukv[l], g_c_q[l], g_c_k[l], sink_d[l], w_branch[l], w_out[l])
        h = h + expert_choice_ffn(rms_norm(h, g_ffn_norm[l]), w_router[l], w_exp_gate[l], w_exp_up[l], w_exp_down[l])
    return rms_norm(h, g_final)
```

```cpp
#include <hip/hip_runtime.h>
#include <cstdio>
#include <cstdint>
#include <cstddef>

#ifndef MK_PER_PHASE
#define MK_PER_PHASE 0
#endif
#ifndef PROJ_BF16
#define PROJ_BF16 1
#endif
#ifndef A2_SGB
#define A2_SGB 0
#endif
#ifndef ATT_SGB
#define ATT_SGB 1
#endif
#ifndef TSPROBE
#define TSPROBE 0
#endif
#ifndef TSMUL
#define TSMUL 10
#endif
#ifndef TSSEL
#define TSSEL 0
#endif
#ifndef PROBE_REP
#define PROBE_REP 0u
#endif

#define GAS __attribute__((address_space(1)))
#define LAS __attribute__((address_space(3)))
typedef unsigned short bf16_t;
typedef short bf16x8 __attribute__((ext_vector_type(8)));
typedef short s16x4 __attribute__((ext_vector_type(4)));
typedef float f32x2 __attribute__((ext_vector_type(2)));
typedef float f32x4 __attribute__((ext_vector_type(4)));
typedef float f32x16 __attribute__((ext_vector_type(16)));
typedef unsigned u32x2 __attribute__((ext_vector_type(2)));
typedef unsigned u32x4 __attribute__((ext_vector_type(4)));
typedef GAS unsigned gu32;

constexpr int NB = 8, S = 2048, DM = 2048, T = NB * S, DEPTH = 2;
constexpr int N_IN = 15136, NP = 15360;
constexpr int NE = 16, FF = 1024, CAP = 256, NSLOT = NB * NE * CAP;
constexpr float EPS = 1e-6f;
constexpr float LOG2E = 1.4426950408889634f, LN2 = 0.6931471805599453f;

constexpr size_t MiB = 1u << 20;
constexpr size_t WS_CTL = 0, CTL_ZERO_BYTES = 2 * MiB;
constexpr size_t WS_WIN = 2 * MiB;
constexpr size_t WS_WUQ = 62 * MiB;
constexpr size_t WS_WUKV = 63 * MiB;
constexpr size_t WS_WBR = 64 * MiB;
constexpr size_t WS_WOUT = 72 * MiB;
constexpr size_t WS_WGU = 80 * MiB;
constexpr size_t WS_WD = 240 * MiB;
constexpr size_t WS_H = 176 * MiB;
constexpr size_t WS_XN = 272 * MiB;
constexpr size_t WS_PA = 336 * MiB;
constexpr size_t WS_PC = 480 * MiB;
constexpr size_t WS_PD = 504 * MiB;
constexpr size_t WS_PB = 528 * MiB;
constexpr size_t WS_GATE = 560 * MiB;
constexpr size_t WS_HMID = WS_GATE, WS_YE = WS_GATE + 64 * MiB;
constexpr size_t WS_QB = 816 * MiB;
constexpr size_t WS_KVB = 840 * MiB;
constexpr size_t WS_KC = 872 * MiB;
constexpr size_t WS_KPE = 876 * MiB;
constexpr size_t WS_OA3 = 877 * MiB;
constexpr size_t WS_LSE = 925 * MiB;
constexpr size_t WS_OCAT = 927 * MiB;
constexpr size_t WS_PROBS = 991 * MiB;
constexpr size_t WS_IDX = 992 * MiB;
constexpr size_t WS_GV = WS_IDX + 128 * 256 * 4;
constexpr size_t WS_SEL = 993 * MiB;
constexpr size_t WS_ROPE = 994 * MiB;
constexpr size_t WS_SQP = 995 * MiB;
constexpr size_t WS_W8 = WS_WIN;
constexpr size_t WS_XN8 = WS_WGU + 64 * MiB;
constexpr size_t WS_XE = WS_PA;
constexpr size_t WS_END = 996 * MiB;

constexpr int CW_TMO = 0, CW_DIAG = 8;
constexpr int CW_BAR = 4096;
constexpr int CW_SQ = 16384;

constexpr int SCR_BYTES = 139264;
constexpr int MISC_OFF = SCR_BYTES;
constexpr int LDS_BYTES = SCR_BYTES + 512;
constexpr int NWAVES = 8, NTHR = 512;

constexpr int NPH = 11, PH_FINAL = DEPTH * NPH, N_PHASES = PH_FINAL + 1;

__device__ __forceinline__ unsigned f2bf(float f) { unsigned u = __builtin_bit_cast(unsigned, f); return (u + 0x7fffu + ((u >> 16) & 1u)) >> 16; }
typedef __bf16 hwbf16x2 __attribute__((ext_vector_type(2)));
__device__ __forceinline__ unsigned pk2(float lo, float hi) { const f32x2 v = {lo, hi}; const hwbf16x2 b = __builtin_convertvector(v, hwbf16x2); return __builtin_bit_cast(unsigned, b); }
__device__ __forceinline__ unsigned pk4_fp8(float a, float b, float c, float d) { unsigned w = 0; w = __builtin_amdgcn_cvt_pk_fp8_f32(a, b, w, false); w = __builtin_amdgcn_cvt_pk_fp8_f32(c, d, w, true); return w; }
__device__ __forceinline__ float bflo(unsigned w) { return __builtin_bit_cast(float, w << 16); }
__device__ __forceinline__ float bfhi(unsigned w) { return __builtin_bit_cast(float, w & 0xffff0000u); }
__device__ __forceinline__ float bf1(bf16_t b) { return __builtin_bit_cast(float, (unsigned)b << 16); }
__device__ __forceinline__ float wave_sum(float v) {
#pragma unroll
    for (int o = 1; o < 64; o <<= 1) v += __shfl_xor(v, o);
    return v;
}
#define LDS_WAIT() asm volatile("s_waitcnt lgkmcnt(0)" ::: "memory")
#define VM_WAIT() asm volatile("s_waitcnt vmcnt(0)" ::: "memory")
#define RLX_AGENT __ATOMIC_RELAXED, __HIP_MEMORY_SCOPE_AGENT

#define XB_TMO      128
#define XB_XCNT(j)  (256  + 64 * (j))
#define XB_XSUB(j)  (1280 + 64 * (j))
#define XB_XGEN(j)  (2304 + 64 * (j))
#define XB_TOP      3328
#define XB_TOPGEN   3392
#define XCD_BAR_WORDS 3456
#define XB_SPIN_CAP (1u << 22)
__device__ __forceinline__ unsigned xb_ld(unsigned* p)              { return __hip_atomic_load(p, __ATOMIC_RELAXED, __HIP_MEMORY_SCOPE_AGENT); }
__device__ __forceinline__ unsigned xb_add(unsigned* p, unsigned v) { return __hip_atomic_fetch_add(p, v, __ATOMIC_RELAXED, __HIP_MEMORY_SCOPE_AGENT); }
__device__ __forceinline__ unsigned xb_xcc_id() { return (unsigned)__builtin_amdgcn_s_getreg((3 << 11) | 20) & 0xFu; }
#define XB_SPIN(cond, bar) do { unsigned _sp = 0; while (cond) { __builtin_amdgcn_s_sleep(1); \
    if ((++_sp & 255u) == 0u) { if (xb_ld(&(bar)[XB_TMO])) break; if (_sp > XB_SPIN_CAP) { atomicAdd(&(bar)[XB_TMO], 1u); break; } } } } while (0)
struct XcdBarrier { unsigned* bar; unsigned x; volatile LAS unsigned* st; };
__device__ __forceinline__ XcdBarrier xcd_barrier_post(unsigned* bar, volatile LAS unsigned* st) {
    XcdBarrier b; b.bar = bar; b.x = xb_xcc_id(); b.st = st;
    if (threadIdx.x == 0) (void)xb_add(&bar[XB_XCNT(b.x)], 1u);
    return b;
}
__device__ __forceinline__ void xcd_barrier_complete(unsigned* bar, unsigned x, unsigned& nloc, unsigned& nx) {
    const unsigned G = gridDim.x * gridDim.y * gridDim.z;
    unsigned sum, cnt, mine, sp = 0u;
    for (;;) {
        sum = 0u; cnt = 0u; mine = 0u;
#pragma unroll 1
        for (unsigned j = 0; j < 16; ++j) { const unsigned c = xb_ld(&bar[XB_XCNT(j)]); sum += c; cnt += (c > 0u) ? 1u : 0u; mine = (j == x) ? c : mine; }
        if (sum == G) break;
        __builtin_amdgcn_s_sleep(1);
        if ((++sp & 255u) == 0u) { if (xb_ld(&bar[XB_TMO])) break; if (sp > XB_SPIN_CAP) { atomicAdd(&bar[XB_TMO], 1u); break; } }
    }
    nloc = mine > 0u ? mine : 1u; nx = cnt > 0u ? cnt : 1u;
}
__device__ __forceinline__ void xcd_barrier(const XcdBarrier& b) {
    asm volatile("s_waitcnt vmcnt(0)" ::: "memory");
    __syncthreads();
    if (threadIdx.x == 0) {
        unsigned* bar = b.bar;
        __builtin_amdgcn_s_waitcnt(0);
        unsigned nloc = b.st[0], nx = b.st[1];
        if (nloc == 0u) { xcd_barrier_complete(bar, b.x, nloc, nx); b.st[0] = nloc; b.st[1] = nx; }
        const unsigned old = xb_add(&bar[XB_XSUB(b.x)], 1u);
        const unsigned gen = old / nloc;
        if (old + 1u == (gen + 1u) * nloc) {
            __builtin_amdgcn_fence(__ATOMIC_RELEASE, "agent");
            asm volatile("s_waitcnt vmcnt(0)" ::: "memory");
            const unsigned og = xb_add(&bar[XB_TOP], 1u);
            const unsigned tg = og / nx;
            if (og + 1u == (tg + 1u) * nx) xb_add(&bar[XB_TOPGEN], 1u);
            else XB_SPIN(xb_ld(&bar[XB_TOPGEN]) == tg, bar);
            __builtin_amdgcn_fence(__ATOMIC_ACQUIRE, "agent");
            xb_add(&bar[XB_XGEN(b.x)], 1u);
            asm volatile("s_waitcnt vmcnt(0)" ::: "memory");
        } else {
            XB_SPIN(xb_ld(&bar[XB_XGEN(b.x)]) == gen, bar);
            __builtin_amdgcn_fence(__ATOMIC_ACQUIRE, "agent");
            asm volatile("s_waitcnt vmcnt(0)" ::: "memory");
        }
    }
    __syncthreads();
}

namespace pg8 {
constexpr int BM = 256, BK = 64, HALF = 128, HTB = HALF * BK * 2, STAGE_BYTES = 8 * HTB, NXCD = 8, WGM = 4;
__device__ __forceinline__ int lds_byte(int r, int c) { const int st = (r >> 4) * 2 + (c >> 5), rr = r & 15, cc = c & 31, ob = rr * 64 + cc * 2; return st * 1024 + (ob ^ (((ob >> 9) & 1) << 5)); }
__device__ __forceinline__ void stage_rc(int b, int& R, int& C) { const int st = b / 1024, sb = b % 1024, swz = sb ^ (((sb >> 9) & 1) << 5); R = (st >> 1) * 16 + swz / 64; C = (st & 1) * 32 + (swz % 64) / 2; }
__device__ __forceinline__ int perm32(int rho) { const int n = rho >> 4, i = rho & 15; return 8 * (i >> 2) + 4 * n + (i & 3); }

struct Unit { const char* A; const char* B; int pm, pn, aux; };
struct Gemm { int lda, ldb, K; };

__device__ __forceinline__ bool tile_order(int L, int nM, int nN, int& pm, int& pn) {
    const int nwg = nM * nN; if (L >= nwg) return false;
    int wgid = L; { const int q = nwg / NXCD, r = nwg % NXCD, xcd = wgid % NXCD, off = wgid / NXCD; wgid = (xcd < r ? xcd * (q + 1) : r * (q + 1) + (xcd - r) * q) + off; }
    const int nig = WGM * nN, gid = wgid / nig, fm = gid * WGM, gsz = (nM - fm) < WGM ? (nM - fm) : WGM;
    pm = fm + ((wgid % nig) % gsz); pn = (wgid % nig) / gsz; return true;
}
struct TileOrder {
    const char* A; const char* B; int lda, ldb, nM, nN, G, c;
    __device__ __forceinline__ bool next(int i, Unit& u) const {
        int pm, pn; if (!tile_order(i * G + c, nM, nN, pm, pn)) return false;
        u.pm = pm; u.pn = pn; u.aux = 0; u.A = A + (size_t)pm * BM * lda * 2; u.B = B + (size_t)pn * BM * ldb * 2; return true;
    }
};

typedef int i32x8 __attribute__((ext_vector_type(8)));
template <class Epi, class Sched, bool FP8 = false>
__device__ __forceinline__ void gemm_phase(LAS unsigned char* lds, const Gemm g, const Sched& S, const Epi& E) {
    constexpr bool ALIGN_EPI = true;
    int tid_ = threadIdx.x; asm volatile("" : "+v"(tid_));
    const int tid = tid_, wid = __builtin_amdgcn_readfirstlane(tid >> 6), lane = tid & 63, wr = wid >> 2, wc = wid & 3, fr = lane & 15, fq = lane >> 4;
    const int K = g.K, nt = K / BK;
    unsigned voffA[2], voffB[2];
#pragma unroll
    for (int i = 0; i < 2; ++i) { int R, C; stage_rc(tid * 16 + i * 8192, R, C); const int Rb = (R & ~31) + perm32(R & 31);
        voffA[i] = (unsigned)(R * g.lda + C) * 2u; voffB[i] = (unsigned)(Rb * g.ldb + C) * 2u; }
    const size_t kstep = (size_t)(BK * 2);
    const size_t hstepA = (size_t)HALF * g.lda * 2, hstepB = (size_t)HALF * g.ldb * 2;
    const unsigned ldsw = (unsigned)wid * 1024u;
    const int aoff = lds_byte(wr * 64 + fr, fq * 8), boff = lds_byte(wc * 32 + fr, fq * 8);
#define PG8_SA(b, h) (((b) * 2 + (h)) * HTB)
#define PG8_SB(b, h) ((4 + (b) * 2 + (h)) * HTB)
#define PG8_STAGE(bufoff, gbase, voff) do { _Pragma("unroll") for (int _i = 0; _i < 2; ++_i) \
        __builtin_amdgcn_global_load_lds((const unsigned*)((const char*)(gbase) + (voff)[_i]), (LAS unsigned*)(lds + (bufoff) + ldsw + _i * 8192), 16, 0, 0); } while (0)
#define PG8_LDA(dst, b, h) do { _Pragma("unroll") for (int m = 0; m < 4; ++m) _Pragma("unroll") for (int k = 0; k < 2; ++k) dst[m][k] = *(const LAS bf16x8*)(lds + PG8_SA(b, h) + aoff + m * 2048 + k * 1024); } while (0)
#define PG8_LDB(dst, b, h) do { _Pragma("unroll") for (int n = 0; n < 2; ++n) _Pragma("unroll") for (int k = 0; k < 2; ++k) dst[n][k] = *(const LAS bf16x8*)(lds + PG8_SB(b, h) + boff + n * 2048 + k * 1024); } while (0)
#define PG8_CAT(x0, x1) __builtin_bit_cast(i32x8, __builtin_shufflevector(x0, x1, 0, 1, 2, 3, 4, 5, 6, 7, 8, 9, 10, 11, 12, 13, 14, 15))
#define PG8_MMA(ai, bj, At, Bt) do { __builtin_amdgcn_s_setprio(1); _Pragma("unroll") for (int m = 0; m < 4; ++m) _Pragma("unroll") for (int n = 0; n < 2; ++n) { \
        if constexpr (FP8) { const i32x8 b8_ = PG8_CAT(Bt[n][0], Bt[n][1]), a8_ = PG8_CAT(At[m][0], At[m][1]); \
            asm volatile("v_mfma_scale_f32_16x16x128_f8f6f4 %0, %1, %2, %0, %3, %3 op_sel_hi:[0,0,0]" : "+v"(acc[ai][bj][m][n]) : "v"(b8_), "v"(a8_), "v"(sc1)); } \
        else { _Pragma("unroll") for (int k = 0; k < 2; ++k) acc[ai][bj][m][n] = __builtin_amdgcn_mfma_f32_16x16x32_bf16(Bt[n][k], At[m][k], acc[ai][bj][m][n], 0, 0, 0); } } \
        __builtin_amdgcn_s_setprio(0); } while (0)
#define PG8_WAIT_V(n) asm volatile("s_waitcnt vmcnt(" #n ")" ::: "memory")
#define PG8_WAIT_L(n) asm volatile("s_waitcnt lgkmcnt(" #n ")" ::: "memory")
#define PG8_BAR __builtin_amdgcn_s_barrier()
#define PG8_SCHED __builtin_amdgcn_sched_barrier(0)
#define PG8_ZERO() do { _Pragma("unroll") for (int a = 0; a < 2; ++a) _Pragma("unroll") for (int b = 0; b < 2; ++b) _Pragma("unroll") for (int m = 0; m < 4; ++m) _Pragma("unroll") for (int n = 0; n < 2; ++n) acc[a][b][m][n] = (f32x4){0.f, 0.f, 0.f, 0.f}; } while (0)
    int sc1 = 0x7f7f7f7f; asm volatile("" : "+v"(sc1));
    Unit cur, nxt; int ui = 0;
    if (!S.next(0, cur)) return;
    f32x4 acc[2][2][4][2];
    PG8_ZERO();
    bf16x8 At[4][2], B0[2][2], B1[2][2];
    const char* cA = cur.A; const char* cB = cur.B;
    PG8_STAGE(PG8_SB(0, 0), cB, voffB); PG8_STAGE(PG8_SB(0, 1), cB + hstepB, voffB); PG8_STAGE(PG8_SA(0, 0), cA, voffA); PG8_STAGE(PG8_SA(0, 1), cA + hstepA, voffA);
    if (wr == 1) PG8_BAR;
    PG8_WAIT_V(2); PG8_BAR;
    PG8_STAGE(PG8_SB(1, 0), cB + kstep, voffB); PG8_STAGE(PG8_SA(1, 0), cA + kstep, voffA); PG8_STAGE(PG8_SB(1, 1), cB + hstepB + kstep, voffB);
    PG8_WAIT_V(6); PG8_BAR;
    for (;;) {
        const bool has_next = S.next(ui + 1, nxt);
        const char* nA = has_next ? nxt.A : cA; const char* nB = has_next ? nxt.B : cB;
        for (int t = 0; t < nt; t += 2) {
            const bool last = (t == nt - 2);
            const char* a1 = cA + (size_t)(t + 1) * kstep;
            const char* a2 = last ? nA : cA + (size_t)(t + 2) * kstep; const char* b2 = last ? nB : cB + (size_t)(t + 2) * kstep;
            const char* a3 = a2 + kstep; const char* b3 = b2 + kstep;
            PG8_LDB(B0, 0, 0); PG8_LDB(B1, 0, 1); PG8_SCHED; PG8_LDA(At, 0, 0); PG8_STAGE(PG8_SA(1, 1), a1 + hstepA, voffA);
            PG8_WAIT_V(8); PG8_WAIT_L(0); PG8_BAR; PG8_MMA(0, 0, At, B0); PG8_MMA(0, 1, At, B1); PG8_BAR; PG8_SCHED;
            PG8_LDA(At, 0, 1); PG8_STAGE(PG8_SB(0, 0), b2, voffB); PG8_STAGE(PG8_SB(0, 1), b2 + hstepB, voffB); PG8_STAGE(PG8_SA(0, 0), a2, voffA);
            PG8_WAIT_V(8); PG8_WAIT_L(0); PG8_BAR; PG8_MMA(1, 0, At, B0); PG8_MMA(1, 1, At, B1); PG8_BAR; PG8_SCHED;
            PG8_LDB(B0, 1, 0); PG8_LDB(B1, 1, 1); PG8_SCHED; PG8_LDA(At, 1, 0); PG8_STAGE(PG8_SA(0, 1), a2 + hstepA, voffA);
            PG8_WAIT_V(8); PG8_WAIT_L(0); PG8_BAR; PG8_MMA(0, 0, At, B0); PG8_MMA(0, 1, At, B1); PG8_BAR; PG8_SCHED;
            PG8_LDA(At, 1, 1); PG8_STAGE(PG8_SB(1, 0), b3, voffB); PG8_STAGE(PG8_SB(1, 1), b3 + hstepB, voffB); PG8_STAGE(PG8_SA(1, 0), a3, voffA);
            PG8_WAIT_V(8); PG8_WAIT_L(0); PG8_BAR; PG8_MMA(1, 0, At, B0); PG8_MMA(1, 1, At, B1); PG8_BAR; PG8_SCHED;
        }
        if constexpr (ALIGN_EPI) { if (wr == 0) PG8_BAR; }
        if constexpr (FP8) asm volatile("s_nop 15\n\ts_nop 15" ::: "memory");
        E(acc, cur, wr, wc, fr, fq);
        if (!has_next) break;
        if (!E.keep(cur)) PG8_ZERO();
        cur = nxt; cA = nA; cB = nB; ++ui;
        if constexpr (ALIGN_EPI) { if (wr == 1) PG8_BAR; }
    }
    PG8_WAIT_V(0);
    if constexpr (!ALIGN_EPI) { if (wr == 0) PG8_BAR; }
    PG8_BAR;
#undef PG8_SA
#undef PG8_SB
#undef PG8_STAGE
#undef PG8_LDA
#undef PG8_LDB
#undef PG8_MMA
#undef PG8_CAT
#undef PG8_WAIT_V
#undef PG8_WAIT_L
#undef PG8_BAR
#undef PG8_SCHED
#undef PG8_ZERO
}

__device__ __forceinline__ void store8(bf16_t* p, const f32x4 v0, const f32x4 v1) {
    u32x4 w; w.x = pk2(v0[0], v0[1]); w.y = pk2(v0[2], v0[3]); w.z = pk2(v1[0], v1[1]); w.w = pk2(v1[2], v1[3]); *(u32x4*)p = w;
}
struct EpiProj {
    bf16_t *PA, *PC, *PD, *PB; float* sqp; float wscale;
    __device__ __forceinline__ bool keep(const Unit&) const { return false; }
    __device__ __forceinline__ void operator()(f32x4 (&acc)[2][2][4][2], const Unit& u, int wr, int wc, int fr, int fq) const {
        const int pn = u.pn; const int row0 = u.pm * BM + wr * 64 + fr, cl = wc * 32 + 8 * fq;
        bf16_t* dst; int ld, colt;
        if (pn < 18) { dst = PA; ld = 4608; colt = pn * 256; }
        else if (pn < 21) { dst = PC; ld = 768; colt = (pn - 18) * 256; }
        else if (pn < 24) { dst = PD; ld = 768; colt = (pn - 21) * 256; }
        else { dst = PB; ld = 1024; colt = (pn - 24) * 256; }
        {
            const bool dosq = (pn >= 24 && pn < 27);
#pragma unroll
            for (int ai = 0; ai < 2; ++ai)
#pragma unroll
                for (int m = 0; m < 4; ++m) { const int row = row0 + ai * HALF + m * 16; bf16_t* rowp = dst + (size_t)row * ld + colt + cl;
#pragma unroll
                    for (int bj = 0; bj < 2; ++bj) { acc[ai][bj][m][0] = acc[ai][bj][m][0] * wscale; acc[ai][bj][m][1] = acc[ai][bj][m][1] * wscale; store8(rowp + bj * HALF, acc[ai][bj][m][0], acc[ai][bj][m][1]); } }
            if (dosq) {
#pragma unroll
                for (int ai = 0; ai < 2; ++ai)
#pragma unroll
                    for (int m = 0; m < 4; ++m) { const int row = row0 + ai * HALF + m * 16; float s = 0.f;
#pragma unroll
                        for (int bj = 0; bj < 2; ++bj) { const f32x4 v0 = acc[ai][bj][m][0], v1 = acc[ai][bj][m][1];
                            s += (v0[0] * v0[0] + v0[1] * v0[1]) + (v0[2] * v0[2] + v0[3] * v0[3]) + (v1[0] * v1[0] + v1[1] * v1[1]) + (v1[2] * v1[2] + v1[3] * v1[3]); }
                        s += __shfl_xor(s, 16); s += __shfl_xor(s, 32); if (fq == 0) sqp[(size_t)row * 12 + (pn - 24) * 4 + wc] = s; }
            }
        }
    }
};
struct EpiMla {
    bf16_t* O; int ld; const float* sqp; int s0, ns; float invn;
    __device__ __forceinline__ bool keep(const Unit&) const { return false; }
    __device__ __forceinline__ void operator()(f32x4 (&acc)[2][2][4][2], const Unit& u, int wr, int wc, int fr, int fq) const {
        const int row0 = u.pm * BM + wr * 64 + fr, col0 = u.pn * BM + wc * 32 + 8 * fq;
#pragma unroll
        for (int ai = 0; ai < 2; ++ai)
#pragma unroll
            for (int m = 0; m < 4; ++m) { const int row = row0 + ai * HALF + m * 16; float ssum = 0.f; for (int q = 0; q < ns; ++q) ssum += sqp[(size_t)row * 12 + s0 + q]; const float rs = 1.0f / sqrtf(ssum * invn + EPS); bf16_t* rowp = O + (size_t)row * ld + col0;
#pragma unroll
                for (int bj = 0; bj < 2; ++bj) store8(rowp + bj * HALF, acc[ai][bj][m][0] * rs, acc[ai][bj][m][1] * rs);
                asm volatile("" ::: "memory"); }
    }
};
struct EpiGate {
    bf16_t* R; const float* bgate; float wscale;
    __device__ __forceinline__ bool keep(const Unit&) const { return false; }
    __device__ __forceinline__ void operator()(f32x4 (&acc)[2][2][4][2], const Unit& u, int wr, int wc, int fr, int fq) const {
        const int row0 = u.pm * BM + wr * 64 + fr, ch = u.pn * 64 + wc * 16 + 4 * fq;
#pragma unroll
        for (int ai = 0; ai < 2; ++ai)
#pragma unroll
            for (int m = 0; m < 4; ++m) { bf16_t* rp = R + (size_t)(row0 + ai * HALF + m * 16) * 8192 + ch; float r[4][4];
                const f32x4 b0 = *(const f32x4*)(bgate + ch), b1 = *(const f32x4*)(bgate + 2048 + ch), b2 = *(const f32x4*)(bgate + 4096 + ch), b3 = *(const f32x4*)(bgate + 6144 + ch);
#pragma unroll
                for (int e = 0; e < 4; ++e) {
                    const float d0 = 1.0f + __builtin_amdgcn_exp2f(-LOG2E * (acc[ai][0][m][0][e] * wscale + b0[e])), d1 = 1.0f + __builtin_amdgcn_exp2f(-LOG2E * (acc[ai][0][m][1][e] * wscale + b1[e]));
                    const float d2 = 1.0f + __builtin_amdgcn_exp2f(-LOG2E * (acc[ai][1][m][0][e] * wscale + b2[e])), d3 = 1.0f + __builtin_amdgcn_exp2f(-LOG2E * (acc[ai][1][m][1][e] * wscale + b3[e]));
                    r[0][e] = d1 * __builtin_amdgcn_rcpf(d0); r[1][e] = d2 * __builtin_amdgcn_rcpf(d1); r[2][e] = d3 * __builtin_amdgcn_rcpf(d2); r[3][e] = __builtin_amdgcn_rcpf(d3); }
#pragma unroll
                for (int i = 0; i < 4; ++i) { u32x2 w; w.x = pk2(r[i][0], r[i][1]); w.y = pk2(r[i][2], r[i][3]); *(u32x2*)(rp + i * 2048) = w; }
                asm volatile("" ::: "memory"); }
    }
};
struct EpiMerge {
    const bf16_t* GT; bf16_t* O;
    __device__ __forceinline__ bool keep(const Unit& u) const { return u.aux != 3; }
    __device__ __forceinline__ void operator()(f32x4 (&acc)[2][2][4][2], const Unit& u, int wr, int wc, int fr, int fq) const {
        const int row0 = u.pm * BM + wr * 64 + fr, col0 = u.pn * BM + wc * 32 + 8 * fq; const int br = u.aux;
        u32x4 gr[2][4][2];
#pragma unroll
        for (int ai = 0; ai < 2; ++ai)
#pragma unroll
            for (int m = 0; m < 4; ++m)
#pragma unroll
                for (int bj = 0; bj < 2; ++bj) gr[ai][m][bj] = *(const u32x4*)(GT + (size_t)(row0 + ai * HALF + m * 16) * 8192 + br * 2048 + col0 + bj * HALF);
#pragma unroll
        for (int ai = 0; ai < 2; ++ai)
#pragma unroll
            for (int m = 0; m < 4; ++m)
#pragma unroll
                for (int bj = 0; bj < 2; ++bj) { const u32x4 g0 = gr[ai][m][bj];
                    acc[ai][bj][m][0][0] *= bflo(g0.x); acc[ai][bj][m][0][1] *= bfhi(g0.x); acc[ai][bj][m][0][2] *= bflo(g0.y); acc[ai][bj][m][0][3] *= bfhi(g0.y);
                    acc[ai][bj][m][1][0] *= bflo(g0.z); acc[ai][bj][m][1][1] *= bfhi(g0.z); acc[ai][bj][m][1][2] *= bflo(g0.w); acc[ai][bj][m][1][3] *= bfhi(g0.w);
                    if (br == 3) store8(O + (size_t)(row0 + ai * HALF + m * 16) * 2048 + col0 + bj * HALF, acc[ai][bj][m][0], acc[ai][bj][m][1]); }
    }
};
struct EpiOut {
    const float* hin32; const bf16_t* hin16; bf16_t* hout;
    __device__ __forceinline__ bool keep(const Unit&) const { return false; }
    __device__ __forceinline__ void operator()(f32x4 (&acc)[2][2][4][2], const Unit& u, int wr, int wc, int fr, int fq) const {
        const int row0 = u.pm * BM + wr * 64 + fr, col0 = u.pn * BM + wc * 32 + 8 * fq;
#pragma unroll
        for (int ai = 0; ai < 2; ++ai)
#pragma unroll
            for (int m = 0; m < 4; ++m) { const size_t off = (size_t)(row0 + ai * HALF + m * 16) * 2048 + col0;
#pragma unroll
                for (int bj = 0; bj < 2; ++bj) { f32x4 b0, b1;
                    if (hin32) { b0 = *(const f32x4*)(hin32 + off + bj * HALF); b1 = *(const f32x4*)(hin32 + off + bj * HALF + 4); }
                    else { const u32x4 w = *(const u32x4*)(hin16 + off + bj * HALF); b0 = (f32x4){bflo(w.x), bfhi(w.x), bflo(w.y), bfhi(w.y)}; b1 = (f32x4){bflo(w.z), bfhi(w.z), bflo(w.w), bfhi(w.w)}; }
                    store8(hout + off + bj * HALF, b0 + acc[ai][bj][m][0], b1 + acc[ai][bj][m][1]); } }
    }
};
struct EpiGateUp {
    unsigned char* H;
    __device__ __forceinline__ bool keep(const Unit&) const { return false; }
    __device__ __forceinline__ void operator()(f32x4 (&acc)[2][2][4][2], const Unit& u, int wr, int wc, int fr, int fq) const {
        const int row0 = u.pm * BM + wr * 64 + fr, col0 = u.pn * 128 + wc * 32 + 8 * fq;
#pragma unroll
        for (int ai = 0; ai < 2; ++ai)
#pragma unroll
            for (int m = 0; m < 4; ++m) { f32x4 v[2];
#pragma unroll
                for (int n = 0; n < 2; ++n)
#pragma unroll
                    for (int e = 0; e < 4; ++e) { const float gte = acc[ai][0][m][n][e] * (1.0f / 64.0f), up = acc[ai][1][m][n][e] * (8.0f / 64.0f); v[n][e] = gte * __builtin_amdgcn_rcpf(1.0f + __builtin_amdgcn_exp2f(-LOG2E * gte)) * up; }
                u32x2 w; w.x = pk4_fp8(v[0][0], v[0][1], v[0][2], v[0][3]); w.y = pk4_fp8(v[1][0], v[1][1], v[1][2], v[1][3]);
                *(u32x2*)(H + (size_t)(row0 + ai * HALF + m * 16) * FF + col0) = w; }
    }
};
struct EpiDown {
    bf16_t* Y; const float* gv;
    __device__ __forceinline__ bool keep(const Unit&) const { return false; }
    __device__ __forceinline__ void operator()(f32x4 (&acc)[2][2][4][2], const Unit& u, int wr, int wc, int fr, int fq) const {
        const int row0 = u.pm * BM + wr * 64 + fr, col0 = u.pn * BM + wc * 32 + 8 * fq;
#pragma unroll
        for (int ai = 0; ai < 2; ++ai)
#pragma unroll
            for (int m = 0; m < 4; ++m) { const int row = row0 + ai * HALF + m * 16; const float gs = gv[row] * (1.0f / 256.0f); bf16_t* rowp = Y + (size_t)row * 2048 + col0;
#pragma unroll
                for (int bj = 0; bj < 2; ++bj) store8(rowp + bj * HALF, acc[ai][bj][m][0] * gs, acc[ai][bj][m][1] * gs); }
    }
};
}

struct Args { const float* in[19]; float* out; unsigned char* ws; int ph_lo, ph_hi; };
enum { I_X = 0, I_WIN, I_BGATE, I_GATTN, I_GFFN, I_GMQ, I_GMKV, I_WUQ, I_WUKV, I_GCQ, I_GCK, I_SINK, I_WBR, I_WOUT, I_WROUTER, I_WEG, I_WEU, I_WED, I_GFINAL };

typedef const __attribute__((address_space(4))) unsigned char* kargp_t;
#define KARG_IN(kp, i) (*(const float* const __attribute__((address_space(4)))*)((kp) + 8 * (i)))
#define KARG_OUT(kp) (*(float* const __attribute__((address_space(4)))*)((kp) + 152))
#define KARG_WS(kp) (*(unsigned char* const __attribute__((address_space(4)))*)((kp) + 160))
#define KARG_LO(kp) (*(const int __attribute__((address_space(4)))*)((kp) + 168))
#define KARG_HI(kp) (*(const int __attribute__((address_space(4)))*)((kp) + 172))
struct Frame {
    LAS unsigned char* lds; gu32* ctl; unsigned char* ws; kargp_t kp;
    int tid, lane, wave, bid, G;
};

__device__ __forceinline__ void conv_item(const float* src, int N, bf16_t* dst, int ld, int k0, int n0, int rowbase, const float* g, LAS float* scr, int lane) {
    f32x4 v[16];
    const int kr = lane >> 3, nc = 4 * (lane & 7);
#pragma unroll
    for (int i = 0; i < 16; ++i) v[i] = *(const f32x4*)(src + (size_t)(k0 + kr + 8 * i) * N + n0 + nc);
    if (g) {
#pragma unroll
        for (int i = 0; i < 16; ++i) v[i] = v[i] * g[k0 + kr + 8 * i];
    }
#pragma unroll
    for (int i = 0; i < 16; ++i) { LAS float* p = scr + (kr + 8 * i) * 33 + nc; p[0] = v[i][0]; p[1] = v[i][1]; p[2] = v[i][2]; p[3] = v[i][3]; }
    LDS_WAIT(); asm volatile("" ::: "memory");
    const int c = lane & 15;
#pragma unroll
    for (int j = 0; j < 8; ++j) { const int n = (lane >> 4) + 4 * j; const LAS float* s = scr + (8 * c) * 33 + n;
        u32x4 o; o.x = pk2(s[0], s[33]); o.y = pk2(s[2 * 33], s[3 * 33]); o.z = pk2(s[4 * 33], s[5 * 33]); o.w = pk2(s[6 * 33], s[7 * 33]);
        *(u32x4*)(dst + (size_t)(rowbase + n) * ld + k0 + 8 * c) = o; }
    LDS_WAIT(); asm volatile("" ::: "memory");
}
__device__ __forceinline__ void conv_item_gate(const float* src, int N, unsigned char* dst, int k0, int n0, int br, int ch0, LAS float* scr, int lane, int ldb = 2048, float sc = 64.f) {
    f32x4 v[16];
    const int kr = lane >> 3, nc = 4 * (lane & 7);
#pragma unroll
    for (int i = 0; i < 16; ++i) v[i] = *(const f32x4*)(src + (size_t)(k0 + kr + 8 * i) * N + n0 + nc);
#pragma unroll
    for (int i = 0; i < 16; ++i) { LAS float* p = scr + (kr + 8 * i) * 33 + nc; p[0] = v[i][0]; p[1] = v[i][1]; p[2] = v[i][2]; p[3] = v[i][3]; }
    LDS_WAIT(); asm volatile("" ::: "memory");
    const int c16 = lane & 15;
#pragma unroll
    for (int j = 0; j < 8; ++j) { const int n = (lane >> 4) + 4 * j; const LAS float* s = scr + (8 * c16) * 33 + n;
        const int chn = ch0 + n, c = chn & 63; const int row = (br < 0) ? chn : 7168 + (chn >> 6) * 256 + 128 * (br >> 1) + 32 * (c >> 4) + 8 * ((c >> 2) & 3) + 4 * (br & 1) + (c & 3);
        u32x2 o; o.x = pk4_fp8(s[0] * sc, s[33] * sc, s[2 * 33] * sc, s[3 * 33] * sc); o.y = pk4_fp8(s[4 * 33] * sc, s[5 * 33] * sc, s[6 * 33] * sc, s[7 * 33] * sc);
        *(u32x2*)(dst + (size_t)row * ldb + k0 + 8 * c16) = o; }
    LDS_WAIT(); asm volatile("" ::: "memory");
}
__device__ __forceinline__ int win_rowmap(int n) {
    if (n < 4608) return n;
    if (n < 5408) return 6144 + (n - 4608);
    if (n < 6176) return 4608 + (n - 5408);
    if (n < 6944) return 5376 + (n - 6176);
    return 7168 + (n - 6944);
}
__device__ __forceinline__ void conv_layer(const Frame& F, int l) {
    LAS float* scr = (LAS float*)(F.lds + F.wave * 16896);
    const int gw = F.bid * NWAVES + F.wave, NGW = F.G * NWAVES, lane = F.lane;
    bf16_t* WIN = (bf16_t*)(F.ws + WS_WIN); bf16_t* WUQ = (bf16_t*)(F.ws + WS_WUQ); bf16_t* WUKV = (bf16_t*)(F.ws + WS_WUKV); bf16_t* WBR = (bf16_t*)(F.ws + WS_WBR);
    bf16_t* WOUT = (bf16_t*)(F.ws + WS_WOUT); bf16_t* WGU = (bf16_t*)(F.ws + WS_WGU); bf16_t* WD = (bf16_t*)(F.ws + WS_WD);
    constexpr int I0 = 16 * 473, I1 = 4 * 24, I2 = 2 * 32, I3 = 4 * 4 * 64, I4 = 16 * 64, I5 = 16 * 16 * 32, I6 = I5, I7 = 16 * 8 * 64;
    constexpr int NIT = I0 + I1 + I2 + I3 + I4 + I5 + I6 + I7;
    for (int it = gw; it < NIT; it += NGW) {
        int r = it;
        if (r < I0) { const int kb = r / 473, nb = r % 473, n0 = nb * 32;
            if (n0 < 6944) { if (PROJ_BF16) conv_item(KARG_IN(F.kp, I_WIN) + (size_t)l * 2048 * N_IN, N_IN, (bf16_t*)(F.ws + WS_WIN + 30 * MiB), 2048, kb * 128, n0, win_rowmap(n0), nullptr, scr, lane);
                             else conv_item_gate(KARG_IN(F.kp, I_WIN) + (size_t)l * 2048 * N_IN, N_IN, (unsigned char*)(F.ws + WS_W8), kb * 128, n0, -1, win_rowmap(n0), scr, lane); }
            else { const int gc = n0 - 6944; conv_item_gate(KARG_IN(F.kp, I_WIN) + (size_t)l * 2048 * N_IN, N_IN, (unsigned char*)(F.ws + WS_W8), kb * 128, n0, gc >> 11, gc & 2047, scr, lane); }
            continue; } r -= I0;
        if (r < I1) { const int kb = r / 24, nb = r % 24; conv_item(KARG_IN(F.kp, I_WUQ) + (size_t)l * 512 * 768, 768, WUQ, 512, kb * 128, nb * 32, nb * 32, KARG_IN(F.kp, I_GMQ) + l * 512, scr, lane); continue; } r -= I1;
        if (r < I2) { const int kb = r / 32, nb = r % 32; conv_item(KARG_IN(F.kp, I_WUKV) + (size_t)l * 256 * 1024, 1024, WUKV, 256, kb * 128, nb * 32, nb * 32, KARG_IN(F.kp, I_GMKV) + l * 256, scr, lane); continue; } r -= I2;
        if (r < I3) { const int br = r / 256, q = r % 256, kb = q / 64, nb = q % 64; conv_item(KARG_IN(F.kp, I_WBR) + (size_t)(l * 4 + br) * 512 * 2048, 2048, WBR + br * 512, 2048, kb * 128, nb * 32, nb * 32, nullptr, scr, lane); continue; } r -= I3;
        if (r < I4) { const int kb = r / 64, nb = r % 64; conv_item(KARG_IN(F.kp, I_WOUT) + (size_t)l * 2048 * 2048, 2048, WOUT, 2048, kb * 128, nb * 32, nb * 32, nullptr, scr, lane); continue; } r -= I4;
        if (r < I5 + I6) { const int up = r >= I5; if (up) r -= I5; const int e = r / 512, q = r % 512, kb = q / 32, nb = q % 32, f0 = nb * 32;
            conv_item_gate(KARG_IN(F.kp, up ? I_WEU : I_WEG) + (size_t)(l * 16 + e) * 2048 * 1024, 1024, (unsigned char*)WGU + (size_t)e * 2048 * 2048, kb * 128, f0, -1, (f0 >> 7) * 256 + up * 128 + (f0 & 127), scr, lane, 2048, 64.f); continue; } r -= I5 + I6;
        { const int e = r / 512, q = r % 512, kb = q / 64, nb = q % 64; conv_item_gate(KARG_IN(F.kp, I_WED) + (size_t)(l * 16 + e) * 1024 * 2048, 2048, (unsigned char*)WD + (size_t)e * 2048 * 1024, kb * 128, nb * 32, -1, nb * 32, scr, lane, 1024, 32.f); }
    }
    for (int i = gw * 64 + lane; i < 224 * 2048 / 16; i += NGW * 64) ((u32x4*)(F.ws + WS_W8 + (size_t)6944 * 2048))[i] = (u32x4){0u, 0u, 0u, 0u};
    if (PROJ_BF16) for (int i = gw * 64 + lane; i < 224 * 2048 / 8; i += NGW * 64) ((u32x4*)(F.ws + WS_WIN + 30 * MiB + (size_t)6944 * 4096))[i] = (u32x4){0u, 0u, 0u, 0u};
    if (l == 0) {
        f32x2* rt = (f32x2*)(F.ws + WS_ROPE);
        for (int i = gw * 64 + lane; i < 2048 * 16; i += NGW * 64) { const int pos = i >> 4, k = i & 15; const float fr = exp2f(-(float)k * (13.287712379549449f / 16.0f)); const float ang = (float)pos * fr; rt[i] = (f32x2){cosf(ang), sinf(ang)}; }
    }
}

template <int MODE>
__device__ __forceinline__ void norm_rows(const Frame& F, const float* hin, float* hout, const float* g, bf16_t* xn) {
    bf16_t* H = (bf16_t*)(F.ws + WS_H);
#define NR_LOAD(dst, row, j) do { if (MODE == 0) dst = *(const f32x4*)(hin + (size_t)(row) * DM + 4 * (lane + 64 * (j))); else { const u32x2 w_ = *(const u32x2*)(H + (size_t)(row) * DM + 4 * (lane + 64 * (j))); dst = (f32x4){bflo(w_.x), bfhi(w_.x), bflo(w_.y), bfhi(w_.y)}; } } while (0)
    const int gw = F.bid * NWAVES + F.wave, NGW = F.G * NWAVES, lane = F.lane;
    const bf16_t* YE = (const bf16_t*)(F.ws + WS_YE); const short* SEL = (const short*)(F.ws + WS_SEL); unsigned char* xn8 = F.ws + WS_XN8;
    f32x4 gv[8];
#pragma unroll
    for (int j = 0; j < 8; ++j) gv[j] = *(const f32x4*)(g + 4 * (lane + 64 * j));
    f32x4 vn[8]; int seln = -1;
    if (gw < T) {
#pragma unroll
        for (int j = 0; j < 8; ++j) NR_LOAD(vn[j], gw, j);
        if (MODE != 0) seln = (lane < NE) ? (int)SEL[(size_t)gw * NE + lane] : -1;
    }
    for (int m = gw; m < T; m += NGW) {
        f32x4 v[8]; const int selv = seln;
#pragma unroll
        for (int j = 0; j < 8; ++j) v[j] = vn[j];
        if (m + NGW < T) {
#pragma unroll
            for (int j = 0; j < 8; ++j) NR_LOAD(vn[j], m + NGW, j);
            if (MODE != 0) seln = (lane < NE) ? (int)SEL[(size_t)(m + NGW) * NE + lane] : -1;
        }
        if (MODE != 0) {
            const int b = m >> 11;
            unsigned mask = (unsigned)__ballot(selv >= 0);
            while (mask) {
                const int e0 = __builtin_ctz(mask); mask &= mask - 1u; const bool two = mask != 0u; const int e1 = two ? __builtin_ctz(mask) : e0; if (two) mask &= mask - 1u;
                const int s0 = __builtin_amdgcn_readlane(selv, e0), s1 = __builtin_amdgcn_readlane(selv, e1);
                const bf16_t* y0 = YE + (size_t)((b * NE + e0) * CAP + s0) * DM; const bf16_t* y1 = YE + (size_t)((b * NE + e1) * CAP + s1) * DM;
                u32x2 w0[8], w1[8];
#pragma unroll
                for (int j = 0; j < 8; ++j) { w0[j] = *(const u32x2*)(y0 + 4 * (lane + 64 * j)); w1[j] = *(const u32x2*)(y1 + 4 * (lane + 64 * j)); }
                const float f1 = two ? 1.0f : 0.0f;
#pragma unroll
                for (int j = 0; j < 8; ++j) { v[j][0] += bflo(w0[j].x) + f1 * bflo(w1[j].x); v[j][1] += bfhi(w0[j].x) + f1 * bfhi(w1[j].x); v[j][2] += bflo(w0[j].y) + f1 * bflo(w1[j].y); v[j][3] += bfhi(w0[j].y) + f1 * bfhi(w1[j].y); }
            }
            if (MODE == 1) {
#pragma unroll
                for (int j = 0; j < 8; ++j) { u32x2 w; w.x = pk2(v[j][0], v[j][1]); w.y = pk2(v[j][2], v[j][3]); *(u32x2*)(H + (size_t)m * DM + 4 * (lane + 64 * j)) = w; }
            }
        }
        float ss = 0.f;
#pragma unroll
        for (int j = 0; j < 8; ++j) ss += (v[j][0] * v[j][0] + v[j][1] * v[j][1]) + (v[j][2] * v[j][2] + v[j][3] * v[j][3]);
        const float rs = 1.0f / sqrtf(wave_sum(ss) * (1.0f / DM) + EPS);
        if (MODE == 2) {
#pragma unroll
            for (int j = 0; j < 8; ++j) *(f32x4*)(hout + (size_t)m * DM + 4 * (lane + 64 * j)) = v[j] * rs * gv[j];
        } else {
#pragma unroll
            for (int j = 0; j < 8; ++j) { const f32x4 o = v[j] * rs * gv[j]; *(unsigned*)(xn8 + (size_t)m * DM + 4 * (lane + 64 * j)) = pk4_fp8(o[0], o[1], o[2], o[3]);
                if (PROJ_BF16) { u32x2 w; w.x = pk2(o[0], o[1]); w.y = pk2(o[2], o[3]); *(u32x2*)(xn + (size_t)m * DM + 4 * (lane + 64 * j)) = w; } }
        }
    }
}
__device__ __forceinline__ void norm2_router(const Frame& F, const bf16_t* h, const float* g, const float* wr, unsigned char* xn, float* probs) {
#define N2_LOAD(dst, row, j) do { const u32x2 w_ = *(const u32x2*)(h + (size_t)(row) * DM + 4 * (lane + 64 * (j))); dst = (f32x4){bflo(w_.x), bfhi(w_.x), bflo(w_.y), bfhi(w_.y)}; } while (0)
    LAS float* wt = (LAS float*)F.lds;
    for (int i = F.tid; i < DM * NE / 4; i += NTHR) { const f32x4 w = *(const f32x4*)(wr + 4 * i); const int col = i >> 2, e0 = (i & 3) * 4;
        wt[(e0 + 0) * DM + col] = w[0]; wt[(e0 + 1) * DM + col] = w[1]; wt[(e0 + 2) * DM + col] = w[2]; wt[(e0 + 3) * DM + col] = w[3]; }
    __syncthreads();
    const int gw = F.bid * NWAVES + F.wave, NGW = F.G * NWAVES, lane = F.lane;
    f32x4 n0[8], n1[8];
    if (2 * gw < T) {
#pragma unroll
        for (int j = 0; j < 8; ++j) { N2_LOAD(n0[j], 2 * gw, j); N2_LOAD(n1[j], 2 * gw + 1, j); }
    }
    for (int m = 2 * gw; m < T; m += 2 * NGW) {
        f32x4 v0[8], v1[8]; float ss0 = 0.f, ss1 = 0.f;
#pragma unroll
        for (int j = 0; j < 8; ++j) { v0[j] = n0[j]; v1[j] = n1[j]; }
        if (m + 2 * NGW < T) {
#pragma unroll
            for (int j = 0; j < 8; ++j) { N2_LOAD(n0[j], m + 2 * NGW, j); N2_LOAD(n1[j], m + 2 * NGW + 1, j); }
        }
#pragma unroll
        for (int j = 0; j < 8; ++j) { ss0 += (v0[j][0] * v0[j][0] + v0[j][1] * v0[j][1]) + (v0[j][2] * v0[j][2] + v0[j][3] * v0[j][3]); ss1 += (v1[j][0] * v1[j][0] + v1[j][1] * v1[j][1]) + (v1[j][2] * v1[j][2] + v1[j][3] * v1[j][3]); }
        const float rs0 = 1.0f / sqrtf(wave_sum(ss0) * (1.0f / DM) + EPS), rs1 = 1.0f / sqrtf(wave_sum(ss1) * (1.0f / DM) + EPS);
#pragma unroll
        for (int j = 0; j < 8; ++j) { const f32x4 gj = *(const f32x4*)(g + 4 * (lane + 64 * j)); v0[j] = v0[j] * rs0 * gj; v1[j] = v1[j] * rs1 * gj;
            *(unsigned*)(xn + (size_t)m * DM + 4 * (lane + 64 * j)) = pk4_fp8(v0[j][0], v0[j][1], v0[j][2], v0[j][3]);
            *(unsigned*)(xn + (size_t)(m + 1) * DM + 4 * (lane + 64 * j)) = pk4_fp8(v1[j][0], v1[j][1], v1[j][2], v1[j][3]); }
        float s0[NE], s1[NE];
#pragma unroll
        for (int e = 0; e < NE; ++e) { f32x2 a0 = {0.f, 0.f}, a1 = {0.f, 0.f};
#pragma unroll
            for (int j = 0; j < 8; ++j) { const f32x4 w = *(const LAS f32x4*)(wt + e * DM + 4 * (lane + 64 * j)); const f32x2 wl = {w[0], w[1]}, wh = {w[2], w[3]};
                a0 = __builtin_elementwise_fma((f32x2){v0[j][0], v0[j][1]}, wl, a0); a0 = __builtin_elementwise_fma((f32x2){v0[j][2], v0[j][3]}, wh, a0);
                a1 = __builtin_elementwise_fma((f32x2){v1[j][0], v1[j][1]}, wl, a1); a1 = __builtin_elementwise_fma((f32x2){v1[j][2], v1[j][3]}, wh, a1); }
            s0[e] = a0[0] + a0[1]; s1[e] = a1[0] + a1[1]; asm volatile("" ::: "memory"); }
        const bool up = lane >= 32;
        float r16[16];
#pragma unroll
        for (int e = 0; e < 16; ++e) { const float keep = up ? s1[e] : s0[e], send = up ? s0[e] : s1[e]; r16[e] = keep + __shfl_xor(send, 32); }
        float r8[8]; { const bool b = (lane & 16) != 0;
#pragma unroll
            for (int e = 0; e < 8; ++e) { const float keep = b ? r16[8 + e] : r16[e], send = b ? r16[e] : r16[8 + e]; r8[e] = keep + __shfl_xor(send, 16); } }
        float r4[4]; { const bool b = (lane & 8) != 0;
#pragma unroll
            for (int e = 0; e < 4; ++e) { const float keep = b ? r8[4 + e] : r8[e], send = b ? r8[e] : r8[4 + e]; r4[e] = keep + __shfl_xor(send, 8); } }
        float r2[2]; { const bool b = (lane & 4) != 0;
#pragma unroll
            for (int e = 0; e < 2; ++e) { const float keep = b ? r4[2 + e] : r4[e], send = b ? r4[e] : r4[2 + e]; r2[e] = keep + __shfl_xor(send, 4); } }
        float lg; { const bool b = (lane & 2) != 0; const float keep = b ? r2[1] : r2[0], send = b ? r2[0] : r2[1]; lg = keep + __shfl_xor(send, 2); }
        lg += __shfl_xor(lg, 1);
        float mx = lg;
#pragma unroll
        for (int o = 2; o < 32; o <<= 1) mx = fmaxf(mx, __shfl_xor(mx, o));
        const float ex = __expf(lg - mx); float den = ex;
#pragma unroll
        for (int o = 2; o < 32; o <<= 1) den += __shfl_xor(den, o);
        if ((lane & 1) == 0) probs[(size_t)(m + (lane >> 5)) * NE + ((lane >> 1) & 15)] = ex / den;
    }
    __syncthreads();
}

__device__ __forceinline__ void prep_rows(const Frame& F, const float* gck) {
    const bf16_t* PC = (const bf16_t*)(F.ws + WS_PC); const bf16_t* PB = (const bf16_t*)(F.ws + WS_PB);
    bf16_t* KC = (bf16_t*)(F.ws + WS_KC); bf16_t* KPE = (bf16_t*)(F.ws + WS_KPE); const f32x2* rt = (const f32x2*)(F.ws + WS_ROPE);
    const int gt = F.bid * NTHR + F.tid, NGT = F.G * NTHR;
    for (int w = gt; w < T * 2; w += NGT) {
        const int hh = w & 1, t = w >> 1, pos = t & (S - 1);
        const u32x4* src = (const u32x4*)(PC + (size_t)t * 768 + 512 + hh * 64);
        u32x4 q[8];
#pragma unroll
        for (int c = 0; c < 8; ++c) q[c] = src[c];
        float x[64];
#pragma unroll
        for (int c = 0; c < 8; ++c) { x[8 * c + 0] = bflo(q[c].x); x[8 * c + 1] = bfhi(q[c].x); x[8 * c + 2] = bflo(q[c].y); x[8 * c + 3] = bfhi(q[c].y); x[8 * c + 4] = bflo(q[c].z); x[8 * c + 5] = bfhi(q[c].z); x[8 * c + 6] = bflo(q[c].w); x[8 * c + 7] = bfhi(q[c].w); }
        float ss = 0.f;
#pragma unroll
        for (int i = 0; i < 64; ++i) ss += x[i] * x[i];
        const float rs = 1.0f / sqrtf(ss * (1.0f / 64.0f) + EPS);
#pragma unroll
        for (int i = 0; i < 64; ++i) x[i] *= rs * gck[i];
        const f32x2* rr = rt + (pos >> 6) * 16; const f32x2* rc = rt + (pos & 63) * 16;
#pragma unroll
        for (int i = 0; i < 16; ++i) { const f32x2 c0 = rr[i], c1 = rc[i]; const float a0 = x[i], a1 = x[16 + i], b0 = x[32 + i], b1 = x[48 + i];
            x[i] = a0 * c0.x - a1 * c0.y; x[16 + i] = a0 * c0.y + a1 * c0.x; x[32 + i] = b0 * c1.x - b1 * c1.y; x[48 + i] = b0 * c1.y + b1 * c1.x; }
        u32x4* d = (u32x4*)(KC + (size_t)t * 128 + hh * 64);
#pragma unroll
        for (int c = 0; c < 8; ++c) { u32x4 o; o.x = pk2(x[8 * c], x[8 * c + 1]); o.y = pk2(x[8 * c + 2], x[8 * c + 3]); o.z = pk2(x[8 * c + 4], x[8 * c + 5]); o.w = pk2(x[8 * c + 6], x[8 * c + 7]); d[c] = o; }
    }
    for (int t = gt; t < T; t += NGT) {
        const int pos = t & (S - 1);
        const u32x4* src = (const u32x4*)(PB + (size_t)t * 1024 + 768);
        u32x4 q[4];
#pragma unroll
        for (int c = 0; c < 4; ++c) q[c] = src[c];
        float x[32];
#pragma unroll
        for (int c = 0; c < 4; ++c) { x[8 * c + 0] = bflo(q[c].x); x[8 * c + 1] = bfhi(q[c].x); x[8 * c + 2] = bflo(q[c].y); x[8 * c + 3] = bfhi(q[c].y); x[8 * c + 4] = bflo(q[c].z); x[8 * c + 5] = bfhi(q[c].z); x[8 * c + 6] = bflo(q[c].w); x[8 * c + 7] = bfhi(q[c].w); }
        const f32x2* rp = rt + pos * 16;
#pragma unroll
        for (int i = 0; i < 16; ++i) { const f32x2 cs = rp[i]; const float a0 = x[i], a1 = x[16 + i]; x[i] = a0 * cs.x - a1 * cs.y; x[16 + i] = a0 * cs.y + a1 * cs.x; }
        u32x4* d = (u32x4*)(KPE + (size_t)t * 32);
#pragma unroll
        for (int c = 0; c < 4; ++c) { u32x4 o; o.x = pk2(x[8 * c], x[8 * c + 1]); o.y = pk2(x[8 * c + 2], x[8 * c + 3]); o.z = pk2(x[8 * c + 4], x[8 * c + 5]); o.w = pk2(x[8 * c + 6], x[8 * c + 7]); d[c] = o; }
    }
}

struct AttnArgs {
    const bf16_t* Q; int qp;
    const bf16_t* K; int kp;
    const bf16_t* K2;
    const bf16_t* V; int vp;
    bf16_t* O; int op;
    float* lse;
    int L0;
    int dshift, ldshift;
    int W;
    float c2, slope2, sink2;
    const float* gq;
    const f32x2* rope;
};
__device__ __forceinline__ int tok_of(int L, int dshift, int ldshift) { const int b = L >> 11, w = L & 2047; return (b << 11) + ((w & ((1 << ldshift) - 1)) << dshift) + (w >> ldshift); }
__device__ __forceinline__ int crow(int r, int hi) { return (r & 3) + 8 * (r >> 2) + 4 * hi; }
__device__ __forceinline__ s16x4 vtr(const LAS unsigned char* p) { return __builtin_bit_cast(s16x4, __builtin_amdgcn_ds_read_tr16_b64_v4i16((LAS s16x4*)p)); }

__device__ __forceinline__ void glds16(const void* gsrc, unsigned lds_dst) { unsigned keep;
    asm volatile("s_mov_b32 %0, m0\n\ts_mov_b32 m0, %2\n\ts_nop 0\n\tglobal_load_lds_dwordx4 %1, off\n\ts_mov_b32 m0, %0" : "=&s"(keep) : "v"(gsrc), "s"(lds_dst) : "memory"); }
template <int DQ, bool BANDED, bool SINK, bool LSE_OUT, int QMODE>
__device__ __forceinline__ void attn_unit(const AttnArgs& a, LAS unsigned char* lds) {
    constexpr int NS = DQ / 16, KB = DQ * 128, SLOT = KB + 8192;
    int tid_ = threadIdx.x; asm volatile("" : "+v"(tid_));
    const int tid = tid_, lane = tid & 63, r32 = lane & 31, hi = lane >> 5; const int wid = __builtin_amdgcn_readfirstlane(tid >> 6);
    const int Ld = 1 << a.ldshift;
    const int Lq0 = a.L0 + 32 * wid, Lq = Lq0 + r32;
    int t0, t1, wlo, whi, llo, lhi, wfull_lo = 0, wfull_hi = 0;
    if (BANDED) {
        const int us = a.L0 & ~(Ld - 1), ue = ((a.L0 + 255) & ~(Ld - 1)) + Ld;
        const int klo = max(a.L0 - a.W, us), khi = min(a.L0 + 256 + a.W, ue);
        t0 = klo >> 6; t1 = (khi + 63) >> 6;
        const int zs = Lq0 & ~(Ld - 1), ze = zs + Ld;
        wlo = max(Lq0 - a.W, zs); whi = min(Lq0 + 32 + a.W, ze);
        llo = max(Lq - a.W, zs); lhi = min(Lq + a.W + 1, ze);
        wfull_lo = max(Lq0 + 31 - a.W, zs); wfull_hi = min(Lq0 + a.W + 1, ze);
    } else { t0 = (a.L0 & ~2047) >> 6; t1 = t0 + 32; wlo = 0; whi = 0; llo = 0; lhi = 0; }
    const float flo = (float)(llo - Lq), fhi = (float)(lhi - 1 - Lq);
    const int vkey = 16 * (wid & 3) + (lane >> 2), vcol = 32 * (wid >> 2) + 8 * (lane & 3);
    const bool rope_wave = (DQ == 96) && (wid < 4);
    const unsigned lds0 = (unsigned)(size_t)lds;
#define ATT_DMA(t, slot) do { const int Lk_ = min(max((t) * 64 + lane, 0), T - 1), Lv_ = min(max((t) * 64 + vkey, 0), T - 1); \
        const int tk_ = tok_of(Lk_, a.dshift, a.ldshift), tv_ = tok_of(Lv_, a.dshift, a.ldshift); const unsigned s_ = lds0 + (unsigned)((slot) * SLOT); \
        glds16(a.K + (size_t)tk_ * a.kp + 8 * wid, (unsigned)__builtin_amdgcn_readfirstlane(s_ + wid * 1024)); \
        if (rope_wave) glds16(a.K2 + (size_t)tk_ * 32 + 8 * wid, (unsigned)__builtin_amdgcn_readfirstlane(s_ + (8 + wid) * 1024)); \
        glds16(a.V + (size_t)tv_ * a.vp + vcol, (unsigned)__builtin_amdgcn_readfirstlane(s_ + KB + wid * 1024)); } while (0)
#define ATT_WAIT(nahead) do { if (rope_wave) { if ((nahead) >= 2) asm volatile("s_waitcnt vmcnt(6)" ::: "memory"); else if ((nahead) == 1) asm volatile("s_waitcnt vmcnt(3)" ::: "memory"); else asm volatile("s_waitcnt vmcnt(0)" ::: "memory"); } \
        else { if ((nahead) >= 2) asm volatile("s_waitcnt vmcnt(4)" ::: "memory"); else if ((nahead) == 1) asm volatile("s_waitcnt vmcnt(2)" ::: "memory"); else asm volatile("s_waitcnt vmcnt(0)" ::: "memory"); } } while (0)
    if (BANDED) { for (int t = t0; t < t1; ++t) ATT_DMA(t, t - t0); }
    else { ATT_DMA(t0, 0); if (t0 + 1 < t1) ATT_DMA(t0 + 1, 1); if (t0 + 2 < t1) ATT_DMA(t0 + 2, 2); }
    const int qtok = tok_of(Lq, a.dshift, a.ldshift);
    bf16x8 qr[NS];
    { const bf16_t* qrow = a.Q + (size_t)qtok * a.qp + 8 * hi;
#pragma unroll
      for (int s = 0; s < NS; ++s) qr[s] = *(const bf16x8*)(qrow + 16 * s); }
    {
        const int pos = qtok & (S - 1);
        float x[NS][8];
#pragma unroll
        for (int s = 0; s < NS; ++s)
#pragma unroll
            for (int j = 0; j < 8; ++j) x[s][j] = bf1((bf16_t)qr[s][j]);
        if (QMODE == 2) {
            float ss = 0.f;
#pragma unroll
            for (int s = 0; s < 4; ++s)
#pragma unroll
                for (int j = 0; j < 8; ++j) ss += x[s][j] * x[s][j];
            ss += __shfl_xor(ss, 32);
            const float rs = 1.0f / sqrtf(ss * (1.0f / 64.0f) + EPS);
#pragma unroll
            for (int s = 0; s < 4; ++s)
#pragma unroll
                for (int j = 0; j < 8; ++j) x[s][j] *= rs * a.gq[16 * s + 8 * hi + j];
            const f32x2* rr = a.rope + (pos >> 6) * 16 + 8 * hi; const f32x2* rc = a.rope + (pos & 63) * 16 + 8 * hi;
#pragma unroll
            for (int j = 0; j < 8; ++j) { const f32x2 c0 = rr[j], c1 = rc[j];
                const float a0 = x[0][j], a1 = x[1][j], b0 = x[2][j], b1 = x[3][j];
                x[0][j] = a0 * c0.x - a1 * c0.y; x[1][j] = a0 * c0.y + a1 * c0.x; x[2][j] = b0 * c1.x - b1 * c1.y; x[3][j] = b0 * c1.y + b1 * c1.x; }
        } else if (QMODE == 1) {
            const f32x2* rp = a.rope + pos * 16 + 8 * hi;
#pragma unroll
            for (int j = 0; j < 8; ++j) { const f32x2 c0 = rp[j]; const float a0 = x[NS - 2][j], a1 = x[NS - 1][j]; x[NS - 2][j] = a0 * c0.x - a1 * c0.y; x[NS - 1][j] = a0 * c0.y + a1 * c0.x; }
        }
#pragma unroll
        for (int s = 0; s < NS; ++s) { u32x4 w;
            w.x = pk2(x[s][0] * a.c2, x[s][1] * a.c2); w.y = pk2(x[s][2] * a.c2, x[s][3] * a.c2); w.z = pk2(x[s][4] * a.c2, x[s][5] * a.c2); w.w = pk2(x[s][6] * a.c2, x[s][7] * a.c2);
            qr[s] = __builtin_bit_cast(bf16x8, w); }
    }
    float m_run = SINK ? a.sink2 : -1e30f, l_run = (SINK && hi == 0) ? 1.0f : 0.0f;
    f32x16 o0, o1;
#pragma unroll
    for (int r = 0; r < 16; ++r) { o0[r] = 0.f; o1[r] = 0.f; }
    const int koff = hi * 1024 + r32 * 16;
    const int voff = KB + ((lane >> 4) & 1) * 32 + (lane & 3) * 8 + (4 * hi + ((lane & 15) >> 2)) * 64;
#define ATT_ACTIVE(t) (!BANDED || (((t) * 64 < whi) && ((t) * 64 + 64 > wlo)))
#define ATT_QK(P0, P1, slot) do { const LAS unsigned char* ks_ = lds + (slot) * SLOT + koff; bf16x8 kf0[NS], kf1[NS]; \
        _Pragma("unroll") for (int s = 0; s < NS; ++s) { kf0[s] = *(const LAS bf16x8*)(ks_ + s * 2048); kf1[s] = *(const LAS bf16x8*)(ks_ + s * 2048 + 512); } \
        _Pragma("unroll") for (int r = 0; r < 16; ++r) { P0[r] = 0.f; P1[r] = 0.f; } \
        _Pragma("unroll") for (int s = 0; s < NS; ++s) { P0 = __builtin_amdgcn_mfma_f32_32x32x16_bf16(kf0[s], qr[s], P0, 0, 0, 0); P1 = __builtin_amdgcn_mfma_f32_32x32x16_bf16(kf1[s], qr[s], P1, 0, 0, 0); } } while (0)
    f32x16 p0, p1, n0, n1;
    int ta = t0, tb = t1;
    if (BANDED) {
        asm volatile("s_waitcnt vmcnt(0)" ::: "memory");
        __builtin_amdgcn_s_barrier(); asm volatile("" ::: "memory");
        ta = max(t0, wlo >> 6); tb = min(t1, (whi + 63) >> 6);
        ATT_QK(p0, p1, ta - t0);
    } else {
        { const int ahead = min(t1 - 1 - t0, 2); ATT_WAIT(ahead); }
        __builtin_amdgcn_s_barrier(); asm volatile("" ::: "memory");
        if (t0 + 3 < t1) ATT_DMA(t0 + 3, 3);
        ATT_QK(p0, p1, 0);
    }
#define ATT_SOFTMAX_PV(t, sl) do { \
            const LAS unsigned char* ks = lds + (sl) * SLOT; \
            float mx; \
            if (BANDED) { \
                const float d0f = (float)((t) * 64 + 4 * hi - Lq); \
                mx = -1e30f; \
                if ((t) * 64 >= wfull_lo && (t) * 64 + 64 <= wfull_hi) {        \
                    _Pragma("unroll") for (int r = 0; r < 16; ++r) { const float df = d0f + (float)((r & 3) + 8 * (r >> 2)); \
                        p0[r] = __builtin_fmaf(-a.slope2, __builtin_fabsf(df), p0[r]); p1[r] = __builtin_fmaf(-a.slope2, __builtin_fabsf(df + 32.f), p1[r]); \
                        mx = __builtin_fmaxf(__builtin_fmaxf(mx, p0[r]), p1[r]); } \
                } else { \
                    _Pragma("unroll") for (int r = 0; r < 16; ++r) { const float df = d0f + (float)((r & 3) + 8 * (r >> 2)), dg = df + 32.f; \
                        const float v0 = __builtin_fmaf(-a.slope2, __builtin_fabsf(df), p0[r]), v1 = __builtin_fmaf(-a.slope2, __builtin_fabsf(dg), p1[r]); \
                        p0[r] = (df >= flo && df <= fhi) ? v0 : -1e30f; p1[r] = (dg >= flo && dg <= fhi) ? v1 : -1e30f; \
                        mx = __builtin_fmaxf(__builtin_fmaxf(mx, p0[r]), p1[r]); } \
                } \
            } else { \
                float ma = __builtin_fmaxf(__builtin_fmaxf(p0[0], p0[1]), p1[0]), mb = __builtin_fmaxf(__builtin_fmaxf(p0[2], p0[3]), p1[1]); \
                ma = __builtin_fmaxf(__builtin_fmaxf(ma, p1[2]), p1[3]); \
                _Pragma("unroll") for (int r = 4; r < 16; r += 4) { ma = __builtin_fmaxf(__builtin_fmaxf(ma, p0[r]), p0[r + 1]); mb = __builtin_fmaxf(__builtin_fmaxf(mb, p0[r + 2]), p0[r + 3]); \
                    ma = __builtin_fmaxf(__builtin_fmaxf(ma, p1[r]), p1[r + 1]); mb = __builtin_fmaxf(__builtin_fmaxf(mb, p1[r + 2]), p1[r + 3]); } \
                mx = __builtin_fmaxf(ma, mb); \
            } \
            mx = __builtin_fmaxf(mx, __shfl_xor(mx, 32)); \
            { const float mn = __builtin_fmaxf(m_run, mx); const float alpha = __builtin_amdgcn_exp2f(m_run - mn); m_run = mn; l_run *= alpha; \
              _Pragma("unroll") for (int r = 0; r < 16; ++r) { o0[r] *= alpha; o1[r] *= alpha; } } \
            float ls0 = 0.f, ls1 = 0.f; \
            _Pragma("unroll") for (int r = 0; r < 16; ++r) { p0[r] = __builtin_amdgcn_exp2f(p0[r] - m_run); p1[r] = __builtin_amdgcn_exp2f(p1[r] - m_run); ls0 += p0[r]; ls1 += p1[r]; } \
            l_run += ls0 + ls1; \
            bf16x8 pf[4]; \
            { u32x4 w; \
              w.x = pk2(p0[0], p0[1]); w.y = pk2(p0[2], p0[3]); w.z = pk2(p0[4], p0[5]); w.w = pk2(p0[6], p0[7]); pf[0] = __builtin_bit_cast(bf16x8, w); \
              w.x = pk2(p0[8], p0[9]); w.y = pk2(p0[10], p0[11]); w.z = pk2(p0[12], p0[13]); w.w = pk2(p0[14], p0[15]); pf[1] = __builtin_bit_cast(bf16x8, w); \
              w.x = pk2(p1[0], p1[1]); w.y = pk2(p1[2], p1[3]); w.z = pk2(p1[4], p1[5]); w.w = pk2(p1[6], p1[7]); pf[2] = __builtin_bit_cast(bf16x8, w); \
              w.x = pk2(p1[8], p1[9]); w.y = pk2(p1[10], p1[11]); w.z = pk2(p1[12], p1[13]); w.w = pk2(p1[14], p1[15]); pf[3] = __builtin_bit_cast(bf16x8, w); } \
            const LAS unsigned char* vs = ks + voff; \
            _Pragma("unroll") for (int kk = 0; kk < 4; ++kk) { \
                const s16x4 a0 = vtr(vs + kk * 1024), a1 = vtr(vs + kk * 1024 + 512), b0 = vtr(vs + 4096 + kk * 1024), b1 = vtr(vs + 4096 + kk * 1024 + 512); \
                const bf16x8 v0 = (bf16x8){a0[0], a0[1], a0[2], a0[3], a1[0], a1[1], a1[2], a1[3]}, v1 = (bf16x8){b0[0], b0[1], b0[2], b0[3], b1[0], b1[1], b1[2], b1[3]}; \
                o0 = __builtin_amdgcn_mfma_f32_32x32x16_bf16(v0, pf[kk], o0, 0, 0, 0); \
                o1 = __builtin_amdgcn_mfma_f32_32x32x16_bf16(v1, pf[kk], o1, 0, 0, 0); } \
        } while (0)
    if (BANDED) {
        for (int t = ta; t < tb; ++t) {
            if (t + 1 < tb) ATT_QK(n0, n1, t + 1 - t0);
            ATT_SOFTMAX_PV(t, t - t0);
            p0 = n0; p1 = n1;
        }
    } else {
        for (int t = t0; t < t1 - 1; ++t) {
            const int sl = (t - t0) & 3;
            { const int ahead = min(t1 - 2 - t, 1); ATT_WAIT(ahead); }
            __builtin_amdgcn_s_barrier(); asm volatile("" ::: "memory");
            if (t >= t0 + 1 && t + 3 < t1) ATT_DMA(t + 3, (sl + 3) & 3);
            ATT_QK(n0, n1, (sl + 1) & 3);
            ATT_SOFTMAX_PV(t, sl);
#pragma unroll
            for (int i = 0; i < (ATT_SGB ? 2 * NS : 0); ++i) { __builtin_amdgcn_sched_group_barrier(0x008, 1, 0); __builtin_amdgcn_sched_group_barrier(0x002, (DQ == 96 ? 9 : 13), 0); }
            p0 = n0; p1 = n1;
        }
        ATT_SOFTMAX_PV(t1 - 1, (t1 - 1 - t0) & 3);
    }
#undef ATT_SOFTMAX_PV
    asm volatile("s_waitcnt lgkmcnt(0)" ::: "memory");
    __builtin_amdgcn_s_barrier();
#undef ATT_ACTIVE
#undef ATT_QK
#undef ATT_DMA
#undef ATT_WAIT
    const float lt = l_run + __shfl_xor(l_run, 32);
    const float inv = 1.0f / lt;
    bf16_t* orow = a.O + (size_t)qtok * a.op + 4 * hi;
#pragma unroll
    for (int g4 = 0; g4 < 4; ++g4) {
        u32x2 w0, w1; w0.x = pk2(o0[4 * g4] * inv, o0[4 * g4 + 1] * inv); w0.y = pk2(o0[4 * g4 + 2] * inv, o0[4 * g4 + 3] * inv);
        w1.x = pk2(o1[4 * g4] * inv, o1[4 * g4 + 1] * inv); w1.y = pk2(o1[4 * g4 + 2] * inv, o1[4 * g4 + 3] * inv);
        *(u32x2*)(orow + 8 * g4) = w0; *(u32x2*)(orow + 32 + 8 * g4) = w1;
    }
    if (LSE_OUT) { if (hi == 0) a.lse[(size_t)qtok * 8] = (m_run + __builtin_amdgcn_logf(lt)) * LN2; }
}

template <int DQ, int QMODE>
__device__ __forceinline__ void load_q(const AttnArgs& a, const bf16_t* Qb, int qtok, int hi, bf16x8 (&qr)[DQ / 16]) {
    constexpr int NS = DQ / 16;
    { const bf16_t* qrow = Qb + (size_t)qtok * a.qp + 8 * hi;
#pragma unroll
      for (int s = 0; s < NS; ++s) qr[s] = *(const bf16x8*)(qrow + 16 * s); }
    const int pos = qtok & (S - 1);
    float x[NS][8];
#pragma unroll
    for (int s = 0; s < NS; ++s)
#pragma unroll
        for (int j = 0; j < 8; ++j) x[s][j] = bf1((bf16_t)qr[s][j]);
    if (QMODE == 2) {
        float ss = 0.f;
#pragma unroll
        for (int s = 0; s < 4; ++s)
#pragma unroll
            for (int j = 0; j < 8; ++j) ss += x[s][j] * x[s][j];
        ss += __shfl_xor(ss, 32);
        const float rs = 1.0f / sqrtf(ss * (1.0f / 64.0f) + EPS);
#pragma unroll
        for (int s = 0; s < 4; ++s)
#pragma unroll
            for (int j = 0; j < 8; ++j) x[s][j] *= rs * a.gq[16 * s + 8 * hi + j];
        const f32x2* rr = a.rope + (pos >> 6) * 16 + 8 * hi; const f32x2* rc = a.rope + (pos & 63) * 16 + 8 * hi;
#pragma unroll
        for (int j = 0; j < 8; ++j) { const f32x2 c0 = rr[j], c1 = rc[j];
            const float a0 = x[0][j], a1 = x[1][j], b0 = x[2][j], b1 = x[3][j];
            x[0][j] = a0 * c0.x - a1 * c0.y; x[1][j] = a0 * c0.y + a1 * c0.x; x[2][j] = b0 * c1.x - b1 * c1.y; x[3][j] = b0 * c1.y + b1 * c1.x; }
    } else if (QMODE == 1) {
        const f32x2* rp = a.rope + pos * 16 + 8 * hi;
#pragma unroll
        for (int j = 0; j < 8; ++j) { const f32x2 c0 = rp[j]; const float a0 = x[NS - 2][j], a1 = x[NS - 1][j]; x[NS - 2][j] = a0 * c0.x - a1 * c0.y; x[NS - 1][j] = a0 * c0.y + a1 * c0.x; }
    }
#pragma unroll
    for (int s = 0; s < NS; ++s) { u32x4 w;
        w.x = pk2(x[s][0] * a.c2, x[s][1] * a.c2); w.y = pk2(x[s][2] * a.c2, x[s][3] * a.c2); w.z = pk2(x[s][4] * a.c2, x[s][5] * a.c2); w.w = pk2(x[s][6] * a.c2, x[s][7] * a.c2);
        qr[s] = __builtin_bit_cast(bf16x8, w); }
}
template <int DQ, int QMODE>
__device__ __forceinline__ void attn_unit2(const AttnArgs& a, int dL, int dQ, int dO, LAS unsigned char* lds) {
    constexpr int NS = DQ / 16, KB = DQ * 128, SLOT = KB + 8192;
    int tid_ = threadIdx.x; asm volatile("" : "+v"(tid_));
    const int tid = tid_, lane = tid & 63, r32 = lane & 31, hi = lane >> 5; const int wid = __builtin_amdgcn_readfirstlane(tid >> 6);
    const int t0 = (a.L0 & ~2047) >> 6, t1 = t0 + 32;
    const int vkey = 16 * (wid & 3) + (lane >> 2), vcol = 32 * (wid >> 2) + 8 * (lane & 3);
    const bool rope_wave = (DQ == 96) && (wid < 4);
    const unsigned lds0 = (unsigned)(size_t)lds;
#define A2_DMA(t, slot) do { const int tk_ = (t) * 64 + lane, tv_ = (t) * 64 + vkey; const unsigned s_ = lds0 + (unsigned)((slot) * SLOT); \
        glds16(a.K + (size_t)tk_ * a.kp + 8 * wid, (unsigned)__builtin_amdgcn_readfirstlane(s_ + wid * 1024)); \
        if (rope_wave) glds16(a.K2 + (size_t)tk_ * 32 + 8 * wid, (unsigned)__builtin_amdgcn_readfirstlane(s_ + (8 + wid) * 1024)); \
        glds16(a.V + (size_t)tv_ * a.vp + vcol, (unsigned)__builtin_amdgcn_readfirstlane(s_ + KB + wid * 1024)); } while (0)
#define A2_WAIT(nahead) do { if (rope_wave) { if ((nahead) >= 2) asm volatile("s_waitcnt vmcnt(6)" ::: "memory"); else if ((nahead) == 1) asm volatile("s_waitcnt vmcnt(3)" ::: "memory"); else asm volatile("s_waitcnt vmcnt(0)" ::: "memory"); } \
        else { if ((nahead) >= 2) asm volatile("s_waitcnt vmcnt(4)" ::: "memory"); else if ((nahead) == 1) asm volatile("s_waitcnt vmcnt(2)" ::: "memory"); else asm volatile("s_waitcnt vmcnt(0)" ::: "memory"); } } while (0)
    A2_DMA(t0, 0); A2_DMA(t0 + 1, 1); A2_DMA(t0 + 2, 2);
    const int Lq = a.L0 + 32 * wid + r32;
    const int qtokA = Lq, qtokB = Lq + dL;
    bf16x8 qa[NS], qb[NS];
    load_q<DQ, QMODE>(a, a.Q, qtokA, hi, qa);
    load_q<DQ, QMODE>(a, a.Q + dQ, qtokB, hi, qb);
    float mA = -1e30f, lA = 0.f, mB = -1e30f, lB = 0.f;
    f32x16 oA0, oA1, oB0, oB1;
#pragma unroll
    for (int r = 0; r < 16; ++r) { oA0[r] = 0.f; oA1[r] = 0.f; oB0[r] = 0.f; oB1[r] = 0.f; }
    const int koff = hi * 1024 + r32 * 16;
    const int voff = KB + ((lane >> 4) & 1) * 32 + (lane & 3) * 8 + (4 * hi + ((lane & 15) >> 2)) * 64;
#define A2_ROWMAX(P0, P1, MX) do { \
        float ma = __builtin_fmaxf(__builtin_fmaxf(P0[0], P0[1]), P1[0]), mb = __builtin_fmaxf(__builtin_fmaxf(P0[2], P0[3]), P1[1]); \
        ma = __builtin_fmaxf(__builtin_fmaxf(ma, P1[2]), P1[3]); \
        _Pragma("unroll") for (int r = 4; r < 16; r += 4) { ma = __builtin_fmaxf(__builtin_fmaxf(ma, P0[r]), P0[r + 1]); mb = __builtin_fmaxf(__builtin_fmaxf(mb, P0[r + 2]), P0[r + 3]); \
            ma = __builtin_fmaxf(__builtin_fmaxf(ma, P1[r]), P1[r + 1]); mb = __builtin_fmaxf(__builtin_fmaxf(mb, P1[r + 2]), P1[r + 3]); } \
        MX = __builtin_fmaxf(ma, mb); } while (0)
#define A2_EXP_PACK(P0, P1, LR, PF) do { \
        float ls0 = 0.f, ls1 = 0.f; \
        _Pragma("unroll") for (int r = 0; r < 16; ++r) { P0[r] = __builtin_amdgcn_exp2f(P0[r]); P1[r] = __builtin_amdgcn_exp2f(P1[r]); ls0 += P0[r]; ls1 += P1[r]; } \
        LR += ls0 + ls1; \
        { u32x4 w; \
          w.x = pk2(P0[0], P0[1]); w.y = pk2(P0[2], P0[3]); w.z = pk2(P0[4], P0[5]); w.w = pk2(P0[6], P0[7]); PF[0] = __builtin_bit_cast(bf16x8, w); \
          w.x = pk2(P0[8], P0[9]); w.y = pk2(P0[10], P0[11]); w.z = pk2(P0[12], P0[13]); w.w = pk2(P0[14], P0[15]); PF[1] = __builtin_bit_cast(bf16x8, w); \
          w.x = pk2(P1[0], P1[1]); w.y = pk2(P1[2], P1[3]); w.z = pk2(P1[4], P1[5]); w.w = pk2(P1[6], P1[7]); PF[2] = __builtin_bit_cast(bf16x8, w); \
          w.x = pk2(P1[8], P1[9]); w.y = pk2(P1[10], P1[11]); w.z = pk2(P1[12], P1[13]); w.w = pk2(P1[14], P1[15]); PF[3] = __builtin_bit_cast(bf16x8, w); } } while (0)
#define A2_TILE(t, FIRST) do { \
        const int sl = ((t) - t0) & 3; \
        { const int ahead = min(t1 - 1 - (t), 2); A2_WAIT(ahead); } \
        __builtin_amdgcn_s_barrier(); asm volatile("" ::: "memory"); \
        if ((t) + 3 < t1) A2_DMA((t) + 3, (sl + 3) & 3); \
        const LAS unsigned char* ks = lds + sl * SLOT; \
        f32x16 a0, a1, b0, b1; \
        { const float ia = FIRST ? 0.f : -mA, ib = FIRST ? 0.f : -mB; \
          _Pragma("unroll") for (int r = 0; r < 16; ++r) { a0[r] = ia; a1[r] = ia; b0[r] = ib; b1[r] = ib; } } \
        _Pragma("unroll") for (int s = 0; s < NS; ++s) { const bf16x8 k0 = *(const LAS bf16x8*)(ks + koff + s * 2048), k1 = *(const LAS bf16x8*)(ks + koff + s * 2048 + 512); \
            a0 = __builtin_amdgcn_mfma_f32_32x32x16_bf16(k0, qa[s], a0, 0, 0, 0); a1 = __builtin_amdgcn_mfma_f32_32x32x16_bf16(k1, qa[s], a1, 0, 0, 0); \
            b0 = __builtin_amdgcn_mfma_f32_32x32x16_bf16(k0, qb[s], b0, 0, 0, 0); b1 = __builtin_amdgcn_mfma_f32_32x32x16_bf16(k1, qb[s], b1, 0, 0, 0); \
            if (DQ == 96) asm volatile("" ::: "memory"); } \
        bf16x8 pfA[4], pfB[4]; float mxA, mxB; \
        A2_ROWMAX(a0, a1, mxA); A2_ROWMAX(b0, b1, mxB); \
        if (FIRST) { mxA = __builtin_fmaxf(mxA, __shfl_xor(mxA, 32)); mxB = __builtin_fmaxf(mxB, __shfl_xor(mxB, 32)); mA = mxA; mB = mxB; \
            _Pragma("unroll") for (int r = 0; r < 16; ++r) { a0[r] -= mxA; a1[r] -= mxA; b0[r] -= mxB; b1[r] -= mxB; } } \
        A2_EXP_PACK(a0, a1, lA, pfA); \
        __builtin_amdgcn_sched_barrier(0); \
        A2_EXP_PACK(b0, b1, lB, pfB); \
        const LAS unsigned char* vs = ks + voff; \
        _Pragma("unroll") for (int kk = 0; kk < 4; ++kk) { \
            const s16x4 x0 = vtr(vs + kk * 1024), x1 = vtr(vs + kk * 1024 + 512), y0 = vtr(vs + 4096 + kk * 1024), y1 = vtr(vs + 4096 + kk * 1024 + 512); \
            const bf16x8 v0 = (bf16x8){x0[0], x0[1], x0[2], x0[3], x1[0], x1[1], x1[2], x1[3]}, v1 = (bf16x8){y0[0], y0[1], y0[2], y0[3], y1[0], y1[1], y1[2], y1[3]}; \
            oA0 = __builtin_amdgcn_mfma_f32_32x32x16_bf16(v0, pfA[kk], oA0, 0, 0, 0); oA1 = __builtin_amdgcn_mfma_f32_32x32x16_bf16(v1, pfA[kk], oA1, 0, 0, 0); \
            oB0 = __builtin_amdgcn_mfma_f32_32x32x16_bf16(v0, pfB[kk], oB0, 0, 0, 0); oB1 = __builtin_amdgcn_mfma_f32_32x32x16_bf16(v1, pfB[kk], oB1, 0, 0, 0); } \
        if (!(FIRST)) { \
            _Pragma("unroll") for (int i = 0; i < (A2_SGB ? 4 * NS + 16 : 0); ++i) { __builtin_amdgcn_sched_group_barrier(0x008, 1, 0); __builtin_amdgcn_sched_group_barrier(0x002, 8, 0); } \
            mxA = __builtin_fmaxf(mxA, __shfl_xor(mxA, 32)); mxB = __builtin_fmaxf(mxB, __shfl_xor(mxB, 32)); \
            if (__any(__builtin_fmaxf(mxA, mxB) > 8.0f)) { \
                const float dA = __builtin_fmaxf(mxA, 0.f), dB = __builtin_fmaxf(mxB, 0.f), fA = __builtin_amdgcn_exp2f(-dA), fB = __builtin_amdgcn_exp2f(-dB); mA += dA; mB += dB; lA *= fA; lB *= fB; \
                _Pragma("unroll") for (int r = 0; r < 16; ++r) { oA0[r] *= fA; oA1[r] *= fA; oB0[r] *= fB; oB1[r] *= fB; } } } \
    } while (0)
    A2_TILE(t0, true);
    for (int t = t0 + 1; t < t1; ++t) A2_TILE(t, false);
#undef A2_TILE
    asm volatile("s_waitcnt lgkmcnt(0)" ::: "memory");
    __builtin_amdgcn_s_barrier();
#undef A2_DMA
#undef A2_WAIT
#undef A2_ROWMAX
#undef A2_EXP_PACK
#define A2_STORE(O0, O1, LR, OB, QT) do { const float lt = LR + __shfl_xor(LR, 32); const float inv = 1.0f / lt; bf16_t* orow = (OB) + (size_t)(QT) * a.op + 4 * hi; \
        _Pragma("unroll") for (int g4 = 0; g4 < 4; ++g4) { u32x2 w0, w1; w0.x = pk2(O0[4 * g4] * inv, O0[4 * g4 + 1] * inv); w0.y = pk2(O0[4 * g4 + 2] * inv, O0[4 * g4 + 3] * inv); \
            w1.x = pk2(O1[4 * g4] * inv, O1[4 * g4 + 1] * inv); w1.y = pk2(O1[4 * g4 + 2] * inv, O1[4 * g4 + 3] * inv); \
            *(u32x2*)(orow + 8 * g4) = w0; *(u32x2*)(orow + 32 + 8 * g4) = w1; } } while (0)
    { int t2_ = threadIdx.x; asm volatile("" : "+v"(t2_));
      const int qA_ = a.L0 + 32 * wid + (t2_ & 31), qB_ = qA_ + dL;
      A2_STORE(oA0, oA1, lA, a.O, qA_);
      A2_STORE(oB0, oB1, lB, a.O + dO, qB_); }
#undef A2_STORE
}

__device__ __forceinline__ void combine_a(const Frame& F) {
    const bf16_t* OA = (const bf16_t*)(F.ws + WS_OA3); const float* LSE = (const float*)(F.ws + WS_LSE); bf16_t* OC = (bf16_t*)(F.ws + WS_OCAT);
    const int gw = F.bid * NWAVES + F.wave, NGW = F.G * NWAVES, lane = F.lane, h = lane >> 3;
    for (int t = gw; t < T; t += NGW) {
        const float l0 = LSE[(size_t)t * 8 + h], l1 = LSE[(size_t)(T + t) * 8 + h], l2 = LSE[(size_t)(2 * T + t) * 8 + h];
        const float mx = fmaxf(l0, fmaxf(l1, l2)); float w0 = __expf(l0 - mx), w1 = __expf(l1 - mx), w2 = __expf(l2 - mx); const float inv = 1.0f / (w0 + w1 + w2); w0 *= inv; w1 *= inv; w2 *= inv;
        const u32x4 a = *(const u32x4*)(OA + (size_t)t * 512 + 8 * lane), b = *(const u32x4*)(OA + (size_t)(T + t) * 512 + 8 * lane), c = *(const u32x4*)(OA + (size_t)(2 * T + t) * 512 + 8 * lane);
        u32x4 o;
        o.x = pk2(w0 * bflo(a.x) + w1 * bflo(b.x) + w2 * bflo(c.x), w0 * bfhi(a.x) + w1 * bfhi(b.x) + w2 * bfhi(c.x));
        o.y = pk2(w0 * bflo(a.y) + w1 * bflo(b.y) + w2 * bflo(c.y), w0 * bfhi(a.y) + w1 * bfhi(b.y) + w2 * bfhi(c.y));
        o.z = pk2(w0 * bflo(a.z) + w1 * bflo(b.z) + w2 * bflo(c.z), w0 * bfhi(a.z) + w1 * bfhi(b.z) + w2 * bfhi(c.z));
        o.w = pk2(w0 * bflo(a.w) + w1 * bflo(b.w) + w2 * bflo(c.w), w0 * bfhi(a.w) + w1 * bfhi(b.w) + w2 * bfhi(c.w));
        *(u32x4*)(OC + (size_t)t * 2048 + 8 * lane) = o;
    }
}

__device__ __forceinline__ void topk_gather(const Frame& F) {
    const float* probs = (const float*)(F.ws + WS_PROBS); int* IDX = (int*)(F.ws + WS_IDX); float* GV = (float*)(F.ws + WS_GV); short* SEL = (short*)(F.ws + WS_SEL);
    const unsigned char* XN = F.ws + WS_XN8; unsigned char* XE = F.ws + WS_XE;
    LAS unsigned* cnt = (LAS unsigned*)F.lds;
    LAS int* lidx = (LAS int*)(F.lds + 256);
    const int tid = F.tid, lane = F.lane, wave = F.wave;
    for (int wu = F.bid; wu < 2 * NB * NE; wu += F.G) {
        const int u = wu >> 1, half = wu & 1, b = u >> 4, e = u & 15;
        unsigned key[4];
#pragma unroll
        for (int j = 0; j < 4; ++j) key[j] = __builtin_bit_cast(unsigned, probs[(size_t)(b * S + 4 * tid + j) * NE + e]);
        unsigned thr = 0u; int needk = CAP;
        LAS unsigned* hist = (LAS unsigned*)(F.lds + 2048);
#pragma unroll 1
        for (int pass = 0; pass < 4; ++pass) {
            const int shift = 24 - 8 * pass;
            if (tid < 256) hist[tid] = 0u;
            __syncthreads();
#pragma unroll
            for (int j = 0; j < 4; ++j) { const bool match = (pass == 0) || ((key[j] >> (shift + 8)) == (thr >> (shift + 8))); if (match) __hip_atomic_fetch_add(hist + ((key[j] >> shift) & 255u), 1u, __ATOMIC_RELAXED, __HIP_MEMORY_SCOPE_WORKGROUP); }
            __syncthreads();
            if (wave == 0) {
                const unsigned h0 = hist[4 * lane], h1 = hist[4 * lane + 1], h2 = hist[4 * lane + 2], h3 = hist[4 * lane + 3];
                const unsigned own = h0 + h1 + h2 + h3; unsigned suf = own;
#pragma unroll
                for (int o = 1; o < 64; o <<= 1) { const unsigned t2 = __shfl_down(suf, o); if (lane + o < 64) suf += t2; }
                const unsigned above = suf - own;
                if (above < (unsigned)needk && suf >= (unsigned)needk) {
                    unsigned acc = above; int bsel; unsigned rem;
                    if (acc + h3 >= (unsigned)needk) { bsel = 4 * lane + 3; rem = (unsigned)needk - acc; }
                    else { acc += h3; if (acc + h2 >= (unsigned)needk) { bsel = 4 * lane + 2; rem = (unsigned)needk - acc; }
                    else { acc += h2; if (acc + h1 >= (unsigned)needk) { bsel = 4 * lane + 1; rem = (unsigned)needk - acc; }
                    else { acc += h1; bsel = 4 * lane; rem = (unsigned)needk - acc; } } }
                    hist[256] = (unsigned)bsel; hist[257] = rem;
                }
            }
            __syncthreads();
            thr |= hist[256] << shift; needk = (int)hist[257];
            __syncthreads();
        }
        int ngt_l = 0, neq_l = 0;
#pragma unroll
        for (int j = 0; j < 4; ++j) { ngt_l += key[j] > thr; neq_l += key[j] == thr; }
        int sg = ngt_l, se = neq_l;
#pragma unroll
        for (int o = 1; o < 64; o <<= 1) { const int a = __shfl_up(sg, o), c2 = __shfl_up(se, o); if (lane >= o) { sg += a; se += c2; } }
        if (lane == 63) { cnt[8 + wave] = (unsigned)sg; cnt[16 + wave] = (unsigned)se; }
        __syncthreads();
        int bg = 0, be = 0, totg = 0;
#pragma unroll
        for (int w = 0; w < NWAVES; ++w) { const int a = (int)cnt[8 + w], c2 = (int)cnt[16 + w]; if (w < wave) { bg += a; be += c2; } totg += a; }
        const int need = CAP - totg;
        int pg = bg + sg - ngt_l, pe = be + se - neq_l;
#pragma unroll
        for (int j = 0; j < 4; ++j) {
            const int tkn = 4 * tid + j; int slot = -1;
            if (key[j] > thr) { slot = pg + min(pe, need); ++pg; }
            else if (key[j] == thr) { if (pe < need) slot = pg + pe; ++pe; }
            if (slot >= 0) { lidx[slot] = tkn; if (half == 0) { IDX[u * CAP + slot] = tkn; GV[u * CAP + slot] = __builtin_bit_cast(float, key[j]); } }
            if (half == 0) SEL[(size_t)(b * S + tkn) * NE + e] = (short)slot;
        }
        __syncthreads();
        for (int r0 = 0; r0 < 16; r0 += 8) { u32x4 buf[8][2];
#pragma unroll
            for (int r = 0; r < 8; ++r) { const int slot = half * 128 + wave * 16 + r0 + r; const int tkn = lidx[slot]; const u32x4* src = (const u32x4*)(XN + (size_t)(b * S + tkn) * DM);
                buf[r][0] = src[lane]; buf[r][1] = src[lane + 64]; }
#pragma unroll
            for (int r = 0; r < 8; ++r) { const int slot = half * 128 + wave * 16 + r0 + r; u32x4* dst = (u32x4*)(XE + (size_t)(u * CAP + slot) * DM);
                dst[lane] = buf[r][0]; dst[lane + 64] = buf[r][1]; } }
        __syncthreads();
    }
}

__global__ void __launch_bounds__(NTHR, 2) fwd_kernel(Args args) {
    extern __shared__ __attribute__((aligned(16))) unsigned char lds_raw[];
    Frame F;
    kargp_t kp = (kargp_t)__builtin_amdgcn_kernarg_segment_ptr(); asm volatile("" : "+s"(kp));
    F.kp = kp; F.lds = (LAS unsigned char*)lds_raw; F.ws = KARG_WS(kp); F.ctl = (gu32*)(F.ws + WS_CTL);
    F.tid = threadIdx.x; F.lane = F.tid & 63; F.wave = __builtin_amdgcn_readfirstlane(F.tid >> 6); F.bid = blockIdx.x; F.G = gridDim.x;
    volatile LAS unsigned* MISC = (volatile LAS unsigned*)(F.lds + MISC_OFF);
    if (F.tid < 128) MISC[F.tid] = 0u;
    __syncthreads();
    XcdBarrier bar; bar.bar = (unsigned*)(F.ctl + CW_BAR); bar.x = 0; bar.st = nullptr;
    if (!MK_PER_PHASE) bar = xcd_barrier_post((unsigned*)(F.ctl + CW_BAR), MISC + 8);
    const int lo = KARG_LO(kp), hi = KARG_HI(kp);
#ifndef PHMASK
#define PHMASK 0xFFFFFFFFu
#endif
#define IN(k) ((((PHMASK) >> ((k) % NPH + ((k) >= PH_FINAL ? NPH : 0))) & 1u) && lo <= (k) && (k) < hi)
#if TSPROBE
    gu32* TSW = F.ctl + 262144;
#define TS_NOW() ((unsigned)__builtin_amdgcn_s_memrealtime())
#define TS_BEGIN(k) do { if (threadIdx.x == 0) { const unsigned tb_ = TS_NOW(); MISC[16] = tb_; __hip_atomic_fetch_max(TSW + 32 + (k), ~tb_, RLX_AGENT); } } while (0)
#define TS_END(k) do { if (threadIdx.x == 0) { const unsigned te_ = TS_NOW(); __hip_atomic_fetch_max(TSW + (k), te_, RLX_AGENT); __hip_atomic_fetch_add(TSW + 64 + (k), te_ - MISC[16], RLX_AGENT); } } while (0)
    TS_BEGIN(0);
#else
#define TS_BEGIN(k) do { } while (0)
#define TS_END(k) do { } while (0)
#endif
#define SEAM(k) do { if (IN(k) && IN((k) + 1)) { TS_END(k); { XcdBarrier b_ = bar; asm volatile("" : "+s"(b_.bar)); xcd_barrier(b_); } TS_BEGIN((k) + 1); } } while (0)
    unsigned char* ws = F.ws;
#define XN ((bf16_t*)(ws + WS_XN))
#define PA ((bf16_t*)(ws + WS_PA))
#define PC ((bf16_t*)(ws + WS_PC))
#define PD ((bf16_t*)(ws + WS_PD))
#define PB ((bf16_t*)(ws + WS_PB))
#define GT ((bf16_t*)(ws + WS_GATE))
#define QB ((bf16_t*)(ws + WS_QB))
#define KVB ((bf16_t*)(ws + WS_KVB))
#define KC ((bf16_t*)(ws + WS_KC))
#define KPE ((bf16_t*)(ws + WS_KPE))
#define OA3 ((bf16_t*)(ws + WS_OA3))
#define LSE ((float*)(ws + WS_LSE))
#define OCAT ((bf16_t*)(ws + WS_OCAT))
#define ROPE ((const f32x2*)(ws + WS_ROPE))
#define out KARG_OUT(kp)
#define PHASE_FRAME() do { int t_ = threadIdx.x; asm volatile("" : "+v"(t_)); F.tid = t_; F.lane = t_ & 63; F.wave = __builtin_amdgcn_readfirstlane(t_ >> 6); } while (0)

    for (int l = 0; l < DEPTH; ++l) {
        const int p0 = l * NPH;
#define REPS(k) ((((PROBE_REP) >> (k)) & 1u) ? 2 : 1)
        { asm volatile("" : "+s"(kp)); F.kp = kp; size_t z_ = 0; asm volatile("" : "+s"(z_)); unsigned char* w_ = KARG_WS(kp) + z_; ws = w_; F.ws = w_; F.ctl = (gu32*)(w_ + WS_CTL);
        }
        float* sqp = (float*)(ws + WS_SQP);
        if (IN(p0 + 0)) { PHASE_FRAME();
            for (int rep = 0; rep < REPS(0); ++rep) conv_layer(F, l);
            if (l == 0) norm_rows<0>(F, KARG_IN(kp, I_X), nullptr, KARG_IN(kp, I_GATTN), XN);
            else norm_rows<1>(F, out, out, KARG_IN(kp, I_GATTN) + l * DM, XN);
        }
        SEAM(p0 + 0);
        if (IN(p0 + 1)) for (int rep = 0; rep < REPS(1); ++rep) { PHASE_FRAME();
            pg8::Gemm g8{1024, 1024, 1024};
            if (PROJ_BF16) { pg8::Gemm g{2048, 2048, 2048};
              pg8::TileOrder So{(const char*)XN, (const char*)(ws + WS_WIN + 30 * MiB), 2048, 2048, T / 256, 28, F.G, F.bid};
              pg8::EpiProj E{PA, PC, PD, PB, sqp, 1.0f};
              pg8::gemm_phase(F.lds, g, So, E); }
            else { pg8::TileOrder So{(const char*)(ws + WS_XN8), (const char*)(ws + WS_W8), 1024, 1024, T / 256, 28, F.G, F.bid};
              pg8::EpiProj E{PA, PC, PD, PB, sqp, 1.0f / 64.0f};
              pg8::gemm_phase<pg8::EpiProj, pg8::TileOrder, true>(F.lds, g8, So, E); }
            { pg8::TileOrder So{(const char*)(ws + WS_XN8), (const char*)(ws + WS_W8 + (size_t)7168 * 2048), 1024, 1024, T / 256, 32, F.G, F.bid};
              pg8::EpiGate E{GT, KARG_IN(kp, I_BGATE) + (size_t)l * 4 * DM, 1.0f / 64.0f};
              pg8::gemm_phase<pg8::EpiGate, pg8::TileOrder, true>(F.lds, g8, So, E); }
        }
        SEAM(p0 + 1);
        if (IN(p0 + 2)) for (int rep = 0; rep < REPS(2); ++rep) { PHASE_FRAME();
            { pg8::Gemm g{1024, 512, 512};
              pg8::TileOrder So{(const char*)PB, (const char*)(ws + WS_WUQ), 1024, 512, T / 256, 3, F.G, F.bid};
              pg8::EpiMla E{QB, 768, sqp, 0, 8, 1.0f / 512.0f};
              pg8::gemm_phase(F.lds, g, So, E); }
            { pg8::Gemm g{1024, 256, 256};
              pg8::TileOrder So{(const char*)(PB + 512), (const char*)(ws + WS_WUKV), 1024, 256, T / 256, 4, F.G, (F.bid + 64) % F.G};
              pg8::EpiMla E{KVB, 1024, sqp, 8, 4, 1.0f / 256.0f};
              pg8::gemm_phase(F.lds, g, So, E); }
            prep_rows(F, KARG_IN(kp, I_GCK) + l * 64);
        }
        SEAM(p0 + 2);
        if (IN(p0 + 3)) for (int rep = 0; rep < REPS(3); ++rep) { PHASE_FRAME();
            for (int rk = 0; rk < REPS(16); ++rk)
            for (int u = F.bid; u < 256; u += F.G) { const int b = u & 7, idx = u >> 3, h = idx >> 2, qb = idx & 3;
                AttnArgs a; a.Q = QB + h * 96; a.qp = 768; a.K = KVB + h * 128; a.kp = 1024; a.K2 = KPE; a.V = KVB + h * 128 + 64; a.vp = 1024; a.O = OCAT + 512 + h * 64; a.op = 2048; a.lse = nullptr;
                a.L0 = b * S + qb * 512; a.dshift = 0; a.ldshift = 11; a.W = 0; a.c2 = 0.10206207261596575f * LOG2E; a.slope2 = 0.f; a.sink2 = 0.f; a.gq = nullptr; a.rope = ROPE;
                attn_unit2<96, 1>(a, 256, 0, 0, F.lds); }
            for (int rk = 0; rk < REPS(17); ++rk)
            for (int u = F.bid; u < 256; u += F.G) { const int b = u & 7, idx = u >> 3, hp = idx >> 3, qb = idx & 7, h = 2 * hp, kvh = h >> 2;
                AttnArgs a; a.Q = PC + h * 64; a.qp = 768; a.K = KC + kvh * 64; a.kp = 128; a.K2 = nullptr; a.V = PC + 640 + kvh * 64; a.vp = 768; a.O = OCAT + 1024 + h * 64; a.op = 2048; a.lse = nullptr;
                a.L0 = b * S + qb * 256; a.dshift = 0; a.ldshift = 11; a.W = 0; a.c2 = 0.125f * LOG2E; a.slope2 = 0.f; a.sink2 = 0.f; a.gq = KARG_IN(kp, I_GCQ) + l * 64; a.rope = ROPE;
                attn_unit2<64, 2>(a, 0, 64, 64, F.lds); }
            for (int rk = 0; rk < REPS(18); ++rk)
            for (int u = F.bid; u < 512; u += F.G) { const int b = u & 7, idx = u >> 3, h = idx >> 3, qb = idx & 7, kvh = h >> 2;
                AttnArgs a; a.Q = PD + h * 64; a.qp = 768; a.K = PD + 512 + kvh * 64; a.kp = 768; a.K2 = nullptr; a.V = PD + 640 + kvh * 64; a.vp = 768; a.O = OCAT + 1536 + h * 64; a.op = 2048; a.lse = nullptr;
                a.L0 = b * S + qb * 256; a.dshift = 0; a.ldshift = 11; a.W = 128; a.c2 = 0.125f * LOG2E; a.slope2 = exp2f(-(float)(h + 1)) * LOG2E; a.sink2 = KARG_IN(kp, I_SINK)[l * 8 + h] * LOG2E; a.gq = nullptr; a.rope = ROPE;
                attn_unit<64, true, true, false, 0>(a, F.lds); }
            for (int rk = 0; rk < REPS(19); ++rk)
            for (int u = F.bid; u < 1536; u += F.G) { const int b = u & 7, idx = u >> 3, g = idx >> 6, h = (idx >> 3) & 7, qb = idx & 7; const int dsh = 2 * g;
                AttnArgs a; a.Q = PA + g * 512 + h * 64; a.qp = 4608; a.K = PA + 1536 + g * 512 + h * 64; a.kp = 4608; a.K2 = nullptr; a.V = PA + 3072 + g * 512 + h * 64; a.vp = 4608;
                a.O = OA3 + (size_t)g * T * 512 + h * 64; a.op = 512; a.lse = LSE + (size_t)g * T * 8 + h;
                a.L0 = b * S + qb * 256; a.dshift = dsh; a.ldshift = 11 - dsh; a.W = 64; a.c2 = 0.125f * LOG2E; a.slope2 = exp2f(-(float)(h + 1)) * (float)(1 << dsh) * LOG2E; a.sink2 = 0.f; a.gq = nullptr; a.rope = ROPE;
                attn_unit<64, true, false, true, 0>(a, F.lds); }
        }
        SEAM(p0 + 3);
        if (IN(p0 + 4)) { PHASE_FRAME(); combine_a(F); }
        SEAM(p0 + 4);
        if (IN(p0 + 5)) for (int rep = 0; rep < REPS(5); ++rep) { PHASE_FRAME();
            struct MergeOrder { const char* A; const char* B; int G, c;
                __device__ __forceinline__ bool next(int i, pg8::Unit& u) const { int pm, pn; if (!pg8::tile_order((i >> 2) * G + c, T / 256, 8, pm, pn)) return false; const int br = i & 3;
                    u.pm = pm; u.pn = pn; u.aux = br; u.A = A + (size_t)pm * 256 * 2048 * 2 + br * 1024; u.B = B + (size_t)pn * 256 * 2048 * 2 + br * 1024; return true; } };
            pg8::Gemm g{2048, 2048, 512};
            MergeOrder So{(const char*)OCAT, (const char*)(ws + WS_WBR), F.G, F.bid};
            pg8::EpiMerge E{GT, XN};
            pg8::gemm_phase(F.lds, g, So, E);
        }
        SEAM(p0 + 5);
        if (IN(p0 + 6)) { PHASE_FRAME();
            pg8::Gemm g{2048, 2048, 2048};
            pg8::TileOrder So{(const char*)XN, (const char*)(ws + WS_WOUT), 2048, 2048, T / 256, 8, F.G, F.bid};
            pg8::EpiOut E{l == 0 ? KARG_IN(kp, I_X) : nullptr, (const bf16_t*)(ws + WS_H), (bf16_t*)(ws + WS_H)};
            pg8::gemm_phase(F.lds, g, So, E);
        }
        SEAM(p0 + 6);
        if (IN(p0 + 7)) for (int rep = 0; rep < REPS(7); ++rep) { PHASE_FRAME(); norm2_router(F, (const bf16_t*)(ws + WS_H), KARG_IN(kp, I_GFFN) + l * DM, KARG_IN(kp, I_WROUTER) + (size_t)l * DM * NE, ws + WS_XN8, (float*)(ws + WS_PROBS)); }
        SEAM(p0 + 7);
        if (IN(p0 + 8)) for (int rep = 0; rep < REPS(8); ++rep) { PHASE_FRAME(); topk_gather(F); }
        SEAM(p0 + 8);
        if (IN(p0 + 9)) for (int rep = 0; rep < REPS(9); ++rep) { PHASE_FRAME();
            struct GuOrder { const char* A; const char* B; int G, c;
                __device__ __forceinline__ bool next(int i, pg8::Unit& u) const { const int L = i * G + c; if (L >= 1024) return false;
                    const int x = L & 7, pn = (L >> 3) & 7, jj = (L >> 6); const int j = jj * 8 + x;
                    const int e = j >> 3, b = j & 7, blk = b * NE + e;
                    u.pm = blk; u.pn = pn; u.aux = 0; u.A = A + (size_t)blk * 256 * 2048; u.B = B + ((size_t)e * 2048 + pn * 256) * 2048; return true; } };
            pg8::Gemm g{1024, 1024, 1024};
            GuOrder So{(const char*)(ws + WS_XE), (const char*)(ws + WS_WGU), F.G, F.bid};
            pg8::EpiGateUp E{ws + WS_HMID};
            pg8::gemm_phase<pg8::EpiGateUp, GuOrder, true>(F.lds, g, So, E);
        }
        SEAM(p0 + 9);
        if (IN(p0 + 10)) for (int rep = 0; rep < REPS(10); ++rep) { PHASE_FRAME();
            struct DnOrder { const char* A; const char* B; int G, c;
                __device__ __forceinline__ bool next(int i, pg8::Unit& u) const { const int L = i * G + c; if (L >= 1024) return false;
                    const int x = L & 7, pn = (L >> 3) & 7, jj = (L >> 6); const int j = jj * 8 + x; const int e = j >> 3, b = j & 7, blk = b * NE + e;
                    u.pm = blk; u.pn = pn; u.aux = 0; u.A = A + (size_t)blk * 256 * 1024; u.B = B + ((size_t)e * 2048 + pn * 256) * 1024; return true; } };
            pg8::Gemm g{512, 512, 512};
            DnOrder So{(const char*)(ws + WS_HMID), (const char*)(ws + WS_WD), F.G, F.bid};
            pg8::EpiDown E{(bf16_t*)(ws + WS_YE), (const float*)(ws + WS_GV)};
            pg8::gemm_phase<pg8::EpiDown, DnOrder, true>(F.lds, g, So, E);
        }
        SEAM(p0 + 10);
    }
    if (IN(PH_FINAL)) { PHASE_FRAME(); norm_rows<2>(F, out, out, KARG_IN(kp, I_GFINAL), nullptr); }
#if TSPROBE
    TS_END(PH_FINAL); xcd_barrier(bar);
    {
        float tail_tot = 0.f, bar_tot = 0.f, tail_sel = 0.f, span_sel = 0.f;
        for (int k = 0; k <= PH_FINAL; ++k) {
            const unsigned mx = __hip_atomic_load(TSW + k, RLX_AGENT), mb = ~__hip_atomic_load(TSW + 32 + k, RLX_AGENT), sb = __hip_atomic_load(TSW + 64 + k, RLX_AGENT);
            const float span = (float)(mx - mb) * 0.01f, busy = (float)sb * 0.01f / (float)F.G;
            tail_tot += span - busy;
            if (k < PH_FINAL) { const unsigned nb = ~__hip_atomic_load(TSW + 32 + k + 1, RLX_AGENT); bar_tot += (float)(int)(nb - mx) * 0.01f; }
            { const int ks = ((TSSEL) > 20 ? (TSSEL) - 21 : (TSSEL) - 1); if (k == ks || (ks < NPH && k == ks + NPH)) { tail_sel += span - busy; span_sel += span; } }
        }
        float stat;
        if (TSSEL == 0) stat = tail_tot; else if (TSSEL == 100) stat = bar_tot; else if (TSSEL <= 20) stat = tail_sel; else stat = span_sel;
        if (F.bid == 0 && F.tid == 0) { const unsigned long long t_end = __builtin_amdgcn_s_memrealtime() + (unsigned long long)(fmaxf(stat, 0.f) * (float)(TSMUL) * 100.0f);
            while (__builtin_amdgcn_s_memrealtime() < t_end) __builtin_amdgcn_s_sleep(8); }
    }
#endif
#undef IN
#undef SEAM
#undef out
#undef XN
#undef PA
#undef PC
#undef PD
#undef PB
#undef GT
#undef QB
#undef KVB
#undef KC
#undef KPE
#undef OA3
#undef LSE
#undef OCAT
#undef ROPE
}
static_assert(offsetof(Args, out) == 152 && offsetof(Args, ws) == 160 && offsetof(Args, ph_lo) == 168 && offsetof(Args, ph_hi) == 172, "KARG_* offsets");

extern "C" void kernel_launch(void* const* d_in, const int* in_sizes, int n_in, void* d_out, int out_size, void* d_ws, size_t ws_size, hipStream_t stream) {
    static int grid = 0;
    if (grid == 0) {
        if (n_in != 19 || out_size != T * DM || ws_size < WS_END) { fprintf(stderr, "kernel_launch: unexpected problem (n_in %d out %d ws %zu need %zu)\n", n_in, out_size, ws_size, (size_t)WS_END); grid = -1; return; }
        int dev = 0, cus = 0, per_cu = 0;
        if (hipGetDevice(&dev) != hipSuccess || hipDeviceGetAttribute(&cus, hipDeviceAttributeMultiprocessorCount, dev) != hipSuccess) { grid = -1; return; }
        if (hipFuncSetAttribute((const void*)fwd_kernel, hipFuncAttributeMaxDynamicSharedMemorySize, LDS_BYTES) != hipSuccess) { fprintf(stderr, "kernel_launch: hipFuncSetAttribute failed\n"); grid = -1; return; }
        if (hipOccupancyMaxActiveBlocksPerMultiprocessor(&per_cu, (const void*)fwd_kernel, NTHR, LDS_BYTES) != hipSuccess || per_cu < 1) fprintf(stderr, "kernel_launch: occupancy query reports %d\n", per_cu);
        (void)hipGetLastError();
        grid = cus;
    }
    if (grid < 0) return;
    (void)hipMemsetAsync((char*)d_ws + WS_CTL, 0, CTL_ZERO_BYTES, stream);
    Args a{};
    for (int i = 0; i < 19; ++i) a.in[i] = (const float*)d_in[i];
    a.out = (float*)d_out; a.ws = (unsigned char*)d_ws;
#if MK_PER_PHASE
    for (int p = 0; p < N_PHASES; ++p) { a.ph_lo = p; a.ph_hi = p + 1; hipLaunchKernelGGL(fwd_kernel, dim3(grid), dim3(NTHR), LDS_BYTES, stream, a); }
#else
    a.ph_lo = 0; a.ph_hi = N_PHASES; hipLaunchKernelGGL(fwd_kernel, dim3(grid), dim3(NTHR), LDS_BYTES, stream, a);
#endif
}
```

```cpp
#include <hip/hip_runtime.h>
#include <cstdio>
#include <cstdint>
#include <cstddef>

#ifndef MK_PER_PHASE
#define MK_PER_PHASE 0
#endif
#ifndef PROJ_BF16
#define PROJ_BF16 0
#endif
#ifndef A2_SGB
#define A2_SGB 0
#endif
#ifndef ATT_SGB
#define ATT_SGB 1
#endif
#ifndef TSPROBE
#define TSPROBE 0
#endif
#ifndef TSMUL
#define TSMUL 10
#endif
#ifndef TSSEL
#define TSSEL 0
#endif
#ifndef PROBE_REP
#define PROBE_REP 0u
#endif

#define GAS __attribute__((address_space(1)))
#define LAS __attribute__((address_space(3)))
typedef unsigned short bf16_t;
typedef short bf16x8 __attribute__((ext_vector_type(8)));
typedef short s16x4 __attribute__((ext_vector_type(4)));
typedef float f32x2 __attribute__((ext_vector_type(2)));
typedef float f32x4 __attribute__((ext_vector_type(4)));
typedef float f32x16 __attribute__((ext_vector_type(16)));
typedef unsigned u32x2 __attribute__((ext_vector_type(2)));
typedef unsigned u32x4 __attribute__((ext_vector_type(4)));
typedef GAS unsigned gu32;

constexpr int NB = 8, S = 2048, DM = 2048, T = NB * S, DEPTH = 2;
constexpr int N_IN = 15136, NP = 15360;
constexpr int NE = 16, FF = 1024, CAP = 256, NSLOT = NB * NE * CAP;
constexpr float EPS = 1e-6f;
constexpr float LOG2E = 1.4426950408889634f, LN2 = 0.6931471805599453f;

constexpr size_t MiB = 1u << 20;
constexpr size_t WS_CTL = 0, CTL_ZERO_BYTES = 2 * MiB;
constexpr size_t WS_WIN = 2 * MiB;
constexpr size_t WS_WUQ = 62 * MiB;
constexpr size_t WS_WUKV = 63 * MiB;
constexpr size_t WS_WBR = 64 * MiB;
constexpr size_t WS_WOUT = 72 * MiB;
constexpr size_t WS_WGU = 80 * MiB;
constexpr size_t WS_WD = 240 * MiB;
constexpr size_t WS_H = 176 * MiB;
constexpr size_t WS_XN = 272 * MiB;
constexpr size_t WS_PA = 336 * MiB;
constexpr size_t WS_PC = 480 * MiB;
constexpr size_t WS_PD = 504 * MiB;
constexpr size_t WS_PB = 528 * MiB;
constexpr size_t WS_GATE = 560 * MiB;
constexpr size_t WS_HMID = WS_GATE, WS_YE = WS_GATE + 64 * MiB;
constexpr size_t WS_QB = 816 * MiB;
constexpr size_t WS_KVB = 840 * MiB;
constexpr size_t WS_KC = 872 * MiB;
constexpr size_t WS_KPE = 876 * MiB;
constexpr size_t WS_OA3 = 877 * MiB;
constexpr size_t WS_LSE = 925 * MiB;
constexpr size_t WS_OCAT = 927 * MiB;
constexpr size_t WS_PROBS = 991 * MiB;
constexpr size_t WS_IDX = 992 * MiB;
constexpr size_t WS_GV = WS_IDX + 128 * 256 * 4;
constexpr size_t WS_SEL = 993 * MiB;
constexpr size_t WS_ROPE = 994 * MiB;
constexpr size_t WS_SQP = 995 * MiB;
constexpr size_t WS_W8 = WS_WIN;
constexpr size_t WS_XN8 = WS_WGU + 64 * MiB;
constexpr size_t WS_XE = WS_PA;
constexpr size_t WS_END = 996 * MiB;

constexpr int CW_TMO = 0, CW_DIAG = 8;
constexpr int CW_BAR = 4096;
constexpr int CW_SQ = 16384;

constexpr int SCR_BYTES = 139264;
constexpr int MISC_OFF = SCR_BYTES;
constexpr int LDS_BYTES = SCR_BYTES + 512;
constexpr int NWAVES = 8, NTHR = 512;

constexpr int NPH = 11, PH_FINAL = DEPTH * NPH, N_PHASES = PH_FINAL + 1;

__device__ __forceinline__ unsigned f2bf(float f) { unsigned u = __builtin_bit_cast(unsigned, f); return (u + 0x7fffu + ((u >> 16) & 1u)) >> 16; }
typedef __bf16 hwbf16x2 __attribute__((ext_vector_type(2)));
__device__ __forceinline__ unsigned pk2(float lo, float hi) { const f32x2 v = {lo, hi}; const hwbf16x2 b = __builtin_convertvector(v, hwbf16x2); return __builtin_bit_cast(unsigned, b); }
__device__ __forceinline__ unsigned pk4_fp8(float a, float b, float c, float d) { unsigned w = 0; w = __builtin_amdgcn_cvt_pk_fp8_f32(a, b, w, false); w = __builtin_amdgcn_cvt_pk_fp8_f32(c, d, w, true); return w; }
__device__ __forceinline__ float bflo(unsigned w) { return __builtin_bit_cast(float, w << 16); }
__device__ __forceinline__ float bfhi(unsigned w) { return __builtin_bit_cast(float, w & 0xffff0000u); }
__device__ __forceinline__ float bf1(bf16_t b) { return __builtin_bit_cast(float, (unsigned)b << 16); }
__device__ __forceinline__ float wave_sum(float v) {
#pragma unroll
    for (int o = 1; o < 64; o <<= 1) v += __shfl_xor(v, o);
    return v;
}
#define LDS_WAIT() asm volatile("s_waitcnt lgkmcnt(0)" ::: "memory")
#define VM_WAIT() asm volatile("s_waitcnt vmcnt(0)" ::: "memory")
#define RLX_AGENT __ATOMIC_RELAXED, __HIP_MEMORY_SCOPE_AGENT

#define XB_TMO      128
#define XB_XCNT(j)  (256  + 64 * (j))
#define XB_XSUB(j)  (1280 + 64 * (j))
#define XB_XGEN(j)  (2304 + 64 * (j))
#define XB_TOP      3328
#define XB_TOPGEN   3392
#define XCD_BAR_WORDS 3456
#define XB_SPIN_CAP (1u << 22)
__device__ __forceinline__ unsigned xb_ld(unsigned* p)              { return __hip_atomic_load(p, __ATOMIC_RELAXED, __HIP_MEMORY_SCOPE_AGENT); }
__device__ __forceinline__ unsigned xb_add(unsigned* p, unsigned v) { return __hip_atomic_fetch_add(p, v, __ATOMIC_RELAXED, __HIP_MEMORY_SCOPE_AGENT); }
__device__ __forceinline__ unsigned xb_xcc_id() { return (unsigned)__builtin_amdgcn_s_getreg((3 << 11) | 20) & 0xFu; }
#define XB_SPIN(cond, bar) do { unsigned _sp = 0; while (cond) { __builtin_amdgcn_s_sleep(1); \
    if ((++_sp & 255u) == 0u) { if (xb_ld(&(bar)[XB_TMO])) break; if (_sp > XB_SPIN_CAP) { atomicAdd(&(bar)[XB_TMO], 1u); break; } } } } while (0)
struct XcdBarrier { unsigned* bar; unsigned x; volatile LAS unsigned* st; };
__device__ __forceinline__ XcdBarrier xcd_barrier_post(unsigned* bar, volatile LAS unsigned* st) {
    XcdBarrier b; b.bar = bar; b.x = xb_xcc_id(); b.st = st;
    if (threadIdx.x == 0) (void)xb_add(&bar[XB_XCNT(b.x)], 1u);
    return b;
}
__device__ __forceinline__ void xcd_barrier_complete(unsigned* bar, unsigned x, unsigned& nloc, unsigned& nx) {
    const unsigned G = gridDim.x * gridDim.y * gridDim.z;
    unsigned sum, cnt, mine, sp = 0u;
    for (;;) {
        sum = 0u; cnt = 0u; mine = 0u;
#pragma unroll 1
        for (unsigned j = 0; j < 16; ++j) { const unsigned c = xb_ld(&bar[XB_XCNT(j)]); sum += c; cnt += (c > 0u) ? 1u : 0u; mine = (j == x) ? c : mine; }
        if (sum == G) break;
        __builtin_amdgcn_s_sleep(1);
        if ((++sp & 255u) == 0u) { if (xb_ld(&bar[XB_TMO])) break; if (sp > XB_SPIN_CAP) { atomicAdd(&bar[XB_TMO], 1u); break; } }
    }
    nloc = mine > 0u ? mine : 1u; nx = cnt > 0u ? cnt : 1u;
}
__device__ __forceinline__ void xcd_barrier(const XcdBarrier& b) {
    asm volatile("s_waitcnt vmcnt(0)" ::: "memory");
    __syncthreads();
    if (threadIdx.x == 0) {
        unsigned* bar = b.bar;
        __builtin_amdgcn_s_waitcnt(0);
        unsigned nloc = b.st[0], nx = b.st[1];
        if (nloc == 0u) { xcd_barrier_complete(bar, b.x, nloc, nx); b.st[0] = nloc; b.st[1] = nx; }
        const unsigned old = xb_add(&bar[XB_XSUB(b.x)], 1u);
        const unsigned gen = old / nloc;
        if (old + 1u == (gen + 1u) * nloc) {
            __builtin_amdgcn_fence(__ATOMIC_RELEASE, "agent");
            asm volatile("s_waitcnt vmcnt(0)" ::: "memory");
            const unsigned og = xb_add(&bar[XB_TOP], 1u);
            const unsigned tg = og / nx;
            if (og + 1u == (tg + 1u) * nx) xb_add(&bar[XB_TOPGEN], 1u);
            else XB_SPIN(xb_ld(&bar[XB_TOPGEN]) == tg, bar);
            __builtin_amdgcn_fence(__ATOMIC_ACQUIRE, "agent");
            xb_add(&bar[XB_XGEN(b.x)], 1u);
            asm volatile("s_waitcnt vmcnt(0)" ::: "memory");
        } else {
            XB_SPIN(xb_ld(&bar[XB_XGEN(b.x)]) == gen, bar);
            __builtin_amdgcn_fence(__ATOMIC_ACQUIRE, "agent");
            asm volatile("s_waitcnt vmcnt(0)" ::: "memory");
        }
    }
    __syncthreads();
}

namespace pg8 {
constexpr int BM = 256, BK = 64, HALF = 128, HTB = HALF * BK * 2, STAGE_BYTES = 8 * HTB, NXCD = 8, WGM = 4;
__device__ __forceinline__ int lds_byte(int r, int c) { const int st = (r >> 4) * 2 + (c >> 5), rr = r & 15, cc = c & 31, ob = rr * 64 + cc * 2; return st * 1024 + (ob ^ (((ob >> 9) & 1) << 5)); }
__device__ __forceinline__ void stage_rc(int b, int& R, int& C) { const int st = b / 1024, sb = b % 1024, swz = sb ^ (((sb >> 9) & 1) << 5); R = (st >> 1) * 16 + swz / 64; C = (st & 1) * 32 + (swz % 64) / 2; }
__device__ __forceinline__ int perm32(int rho) { const int n = rho >> 4, i = rho & 15; return 8 * (i >> 2) + 4 * n + (i & 3); }

struct Unit { const char* A; const char* B; int pm, pn, aux; };
struct Gemm { int lda, ldb, K; };

__device__ __forceinline__ bool tile_order(int L, int nM, int nN, int& pm, int& pn) {
    const int nwg = nM * nN; if (L >= nwg) return false;
    int wgid = L; { const int q = nwg / NXCD, r = nwg % NXCD, xcd = wgid % NXCD, off = wgid / NXCD; wgid = (xcd < r ? xcd * (q + 1) : r * (q + 1) + (xcd - r) * q) + off; }
    const int nig = WGM * nN, gid = wgid / nig, fm = gid * WGM, gsz = (nM - fm) < WGM ? (nM - fm) : WGM;
    pm = fm + ((wgid % nig) % gsz); pn = (wgid % nig) / gsz; return true;
}
struct TileOrder {
    const char* A; const char* B; int lda, ldb, nM, nN, G, c;
    __device__ __forceinline__ bool next(int i, Unit& u) const {
        int pm, pn; if (!tile_order(i * G + c, nM, nN, pm, pn)) return false;
        u.pm = pm; u.pn = pn; u.aux = 0; u.A = A + (size_t)pm * BM * lda * 2; u.B = B + (size_t)pn * BM * ldb * 2; return true;
    }
};

typedef int i32x8 __attribute__((ext_vector_type(8)));
template <class Epi, class Sched, bool FP8 = false>
__device__ __forceinline__ void gemm_phase(LAS unsigned char* lds, const Gemm g, const Sched& S, const Epi& E) {
    constexpr bool ALIGN_EPI = true;
    int tid_ = threadIdx.x; asm volatile("" : "+v"(tid_));
    const int tid = tid_, wid = __builtin_amdgcn_readfirstlane(tid >> 6), lane = tid & 63, wr = wid >> 2, wc = wid & 3, fr = lane & 15, fq = lane >> 4;
    const int K = g.K, nt = K / BK;
    unsigned voffA[2], voffB[2];
#pragma unroll
    for (int i = 0; i < 2; ++i) { int R, C; stage_rc(tid * 16 + i * 8192, R, C); const int Rb = (R & ~31) + perm32(R & 31);
        voffA[i] = (unsigned)(R * g.lda + C) * 2u; voffB[i] = (unsigned)(Rb * g.ldb + C) * 2u; }
    const size_t kstep = (size_t)(BK * 2);
    const size_t hstepA = (size_t)HALF * g.lda * 2, hstepB = (size_t)HALF * g.ldb * 2;
    const unsigned ldsw = (unsigned)wid * 1024u;
    const int aoff = lds_byte(wr * 64 + fr, fq * 8), boff = lds_byte(wc * 32 + fr, fq * 8);
#define PG8_SA(b, h) (((b) * 2 + (h)) * HTB)
#define PG8_SB(b, h) ((4 + (b) * 2 + (h)) * HTB)
#define PG8_STAGE(bufoff, gbase, voff) do { _Pragma("unroll") for (int _i = 0; _i < 2; ++_i) \
        __builtin_amdgcn_global_load_lds((const unsigned*)((const char*)(gbase) + (voff)[_i]), (LAS unsigned*)(lds + (bufoff) + ldsw + _i * 8192), 16, 0, 0); } while (0)
#define PG8_LDA(dst, b, h) do { _Pragma("unroll") for (int m = 0; m < 4; ++m) _Pragma("unroll") for (int k = 0; k < 2; ++k) dst[m][k] = *(const LAS bf16x8*)(lds + PG8_SA(b, h) + aoff + m * 2048 + k * 1024); } while (0)
#define PG8_LDB(dst, b, h) do { _Pragma("unroll") for (int n = 0; n < 2; ++n) _Pragma("unroll") for (int k = 0; k < 2; ++k) dst[n][k] = *(const LAS bf16x8*)(lds + PG8_SB(b, h) + boff + n * 2048 + k * 1024); } while (0)
#define PG8_CAT(x0, x1) __builtin_bit_cast(i32x8, __builtin_shufflevector(x0, x1, 0, 1, 2, 3, 4, 5, 6, 7, 8, 9, 10, 11, 12, 13, 14, 15))
#define PG8_MMA(ai, bj, At, Bt) do { __builtin_amdgcn_s_setprio(1); _Pragma("unroll") for (int m = 0; m < 4; ++m) _Pragma("unroll") for (int n = 0; n < 2; ++n) { \
        if constexpr (FP8) { const i32x8 b8_ = PG8_CAT(Bt[n][0], Bt[n][1]), a8_ = PG8_CAT(At[m][0], At[m][1]); \
            asm volatile("v_mfma_scale_f32_16x16x128_f8f6f4 %0, %1, %2, %0, %3, %3 op_sel_hi:[0,0,0]" : "+v"(acc[ai][bj][m][n]) : "v"(b8_), "v"(a8_), "v"(sc1)); } \
        else { _Pragma("unroll") for (int k = 0; k < 2; ++k) acc[ai][bj][m][n] = __builtin_amdgcn_mfma_f32_16x16x32_bf16(Bt[n][k], At[m][k], acc[ai][bj][m][n], 0, 0, 0); } } \
        __builtin_amdgcn_s_setprio(0); } while (0)
#define PG8_WAIT_V(n) asm volatile("s_waitcnt vmcnt(" #n ")" ::: "memory")
#define PG8_WAIT_L(n) asm volatile("s_waitcnt lgkmcnt(" #n ")" ::: "memory")
#define PG8_BAR __builtin_amdgcn_s_barrier()
#define PG8_SCHED __builtin_amdgcn_sched_barrier(0)
#define PG8_ZERO() do { _Pragma("unroll") for (int a = 0; a < 2; ++a) _Pragma("unroll") for (int b = 0; b < 2; ++b) _Pragma("unroll") for (int m = 0; m < 4; ++m) _Pragma("unroll") for (int n = 0; n < 2; ++n) acc[a][b][m][n] = (f32x4){0.f, 0.f, 0.f, 0.f}; } while (0)
    int sc1 = 0x7f7f7f7f; asm volatile("" : "+v"(sc1));
    Unit cur, nxt; int ui = 0;
    if (!S.next(0, cur)) return;
    f32x4 acc[2][2][4][2];
    PG8_ZERO();
    bf16x8 At[4][2], B0[2][2], B1[2][2];
    const char* cA = cur.A; const char* cB = cur.B;
    PG8_STAGE(PG8_SB(0, 0), cB, voffB); PG8_STAGE(PG8_SB(0, 1), cB + hstepB, voffB); PG8_STAGE(PG8_SA(0, 0), cA, voffA); PG8_STAGE(PG8_SA(0, 1), cA + hstepA, voffA);
    if (wr == 1) PG8_BAR;
    PG8_WAIT_V(2); PG8_BAR;
    PG8_STAGE(PG8_SB(1, 0), cB + kstep, voffB); PG8_STAGE(PG8_SA(1, 0), cA + kstep, voffA); PG8_STAGE(PG8_SB(1, 1), cB + hstepB + kstep, voffB);
    PG8_WAIT_V(6); PG8_BAR;
    for (;;) {
        const bool has_next = S.next(ui + 1, nxt);
        const char* nA = has_next ? nxt.A : cA; const char* nB = has_next ? nxt.B : cB;
        for (int t = 0; t < nt; t += 2) {
            const bool last = (t == nt - 2);
            const char* a1 = cA + (size_t)(t + 1) * kstep;
            const char* a2 = last ? nA : cA + (size_t)(t + 2) * kstep; const char* b2 = last ? nB : cB + (size_t)(t + 2) * kstep;
            const char* a3 = a2 + kstep; const char* b3 = b2 + kstep;
            PG8_LDB(B0, 0, 0); PG8_LDB(B1, 0, 1); PG8_SCHED; PG8_LDA(At, 0, 0); PG8_STAGE(PG8_SA(1, 1), a1 + hstepA, voffA);
            PG8_WAIT_V(8); PG8_WAIT_L(0); PG8_BAR; PG8_MMA(0, 0, At, B0); PG8_MMA(0, 1, At, B1); PG8_BAR; PG8_SCHED;
            PG8_LDA(At, 0, 1); PG8_STAGE(PG8_SB(0, 0), b2, voffB); PG8_STAGE(PG8_SB(0, 1), b2 + hstepB, voffB); PG8_STAGE(PG8_SA(0, 0), a2, voffA);
            PG8_WAIT_V(8); PG8_WAIT_L(0); PG8_BAR; PG8_MMA(1, 0, At, B0); PG8_MMA(1, 1, At, B1); PG8_BAR; PG8_SCHED;
            PG8_LDB(B0, 1, 0); PG8_LDB(B1, 1, 1); PG8_SCHED; PG8_LDA(At, 1, 0); PG8_STAGE(PG8_SA(0, 1), a2 + hstepA, voffA);
            PG8_WAIT_V(8); PG8_WAIT_L(0); PG8_BAR; PG8_MMA(0, 0, At, B0); PG8_MMA(0, 1, At, B1); PG8_BAR; PG8_SCHED;
            PG8_LDA(At, 1, 1); PG8_STAGE(PG8_SB(1, 0), b3, voffB); PG8_STAGE(PG8_SB(1, 1), b3 + hstepB, voffB); PG8_STAGE(PG8_SA(1, 0), a3, voffA);
            PG8_WAIT_V(8); PG8_WAIT_L(0); PG8_BAR; PG8_MMA(1, 0, At, B0); PG8_MMA(1, 1, At, B1); PG8_BAR; PG8_SCHED;
        }
        if constexpr (ALIGN_EPI) { if (wr == 0) PG8_BAR; }
        if constexpr (FP8) asm volatile("s_nop 15\n\ts_nop 15" ::: "memory");
        { int fr_ = fr, fq_ = fq; asm volatile("" : "+v"(fr_), "+v"(fq_));
          E(acc, cur, wr, wc, fr_, fq_); }
        if (!has_next) break;
        if (!E.keep(cur)) PG8_ZERO();
        cur = nxt; cA = nA; cB = nB; ++ui;
        if constexpr (ALIGN_EPI) { if (wr == 1) PG8_BAR; }
    }
    PG8_WAIT_V(0);
    if constexpr (!ALIGN_EPI) { if (wr == 0) PG8_BAR; }
    PG8_BAR;
#undef PG8_SA
#undef PG8_SB
#undef PG8_STAGE
#undef PG8_LDA
#undef PG8_LDB
#undef PG8_MMA
#undef PG8_CAT
#undef PG8_WAIT_V
#undef PG8_WAIT_L
#undef PG8_BAR
#undef PG8_SCHED
#undef PG8_ZERO
}

__device__ __forceinline__ void store8(bf16_t* p, const f32x4 v0, const f32x4 v1) {
    u32x4 w; w.x = pk2(v0[0], v0[1]); w.y = pk2(v0[2], v0[3]); w.z = pk2(v1[0], v1[1]); w.w = pk2(v1[2], v1[3]); *(u32x4*)p = w;
}
struct EpiProj {
    unsigned char* wsb; bf16_t* PB; float* sqp; float wscale;
    __device__ __forceinline__ bool keep(const Unit&) const { return false; }
    __device__ __forceinline__ void operator()(f32x4 (&acc)[2][2][4][2], const Unit& u, int wr, int wc, int fr, int fq) const {
        const int pn = u.pn; const int row0 = u.pm * BM + wr * 64 + fr, cl = wc * 32 + 8 * fq;
        {
            const bool dosq = (pn >= 24 && pn < 27);
            if (pn < 24) {
                bf16_t* hb = (bf16_t*)(wsb + ((pn < 18) ? WS_PA : (pn < 21) ? WS_PC : WS_PD)); const int h0 = ((pn < 18) ? pn : (pn < 21) ? pn - 18 : pn - 21) * 4 + (wc >> 1);
                const int dsh = (pn < 18) ? 2 * ((pn >> 1) % 3) : 0, cih = (wc & 1) * 32 + 8 * fq;
#pragma unroll
                for (int ai = 0; ai < 2; ++ai)
#pragma unroll
                    for (int m = 0; m < 4; ++m) { const int row = row0 + ai * HALF + m * 16; const int w_ = row & 2047; const int pos = (row & ~2047) + ((w_ & ((1 << dsh) - 1)) << (11 - dsh)) + (w_ >> dsh);
                        bf16_t* hp = hb + ((size_t)h0 * T + pos) * 64 + cih;
                        store8(hp, acc[ai][0][m][0] * wscale, acc[ai][0][m][1] * wscale); store8(hp + (size_t)2 * T * 64, acc[ai][1][m][0] * wscale, acc[ai][1][m][1] * wscale);
                        asm volatile("" ::: "memory"); }
            } else {
                bf16_t* dst = PB; const int ld = 1024, colt = (pn - 24) * 256;
#pragma unroll
                for (int ai = 0; ai < 2; ++ai)
#pragma unroll
                    for (int m = 0; m < 4; ++m) { const int row = row0 + ai * HALF + m * 16; bf16_t* rowp = dst + (size_t)row * ld + colt + cl;
#pragma unroll
                        for (int bj = 0; bj < 2; ++bj) store8(rowp + bj * HALF, acc[ai][bj][m][0] * wscale, acc[ai][bj][m][1] * wscale);
                        asm volatile("" ::: "memory"); }
            }
            if (dosq) {
#pragma unroll
                for (int ai = 0; ai < 2; ++ai)
#pragma unroll
                    for (int m = 0; m < 4; ++m) { const int row = row0 + ai * HALF + m * 16; float s = 0.f;
#pragma unroll
                        for (int bj = 0; bj < 2; ++bj) { const f32x4 v0 = acc[ai][bj][m][0], v1 = acc[ai][bj][m][1];
                            s += (v0[0] * v0[0] + v0[1] * v0[1]) + (v0[2] * v0[2] + v0[3] * v0[3]) + (v1[0] * v1[0] + v1[1] * v1[1]) + (v1[2] * v1[2] + v1[3] * v1[3]); }
                        s += __shfl_xor(s, 16); s += __shfl_xor(s, 32); if (fq == 0) sqp[(size_t)row * 12 + (pn - 24) * 4 + wc] = s * (wscale * wscale); }
            }
        }
    }
};
struct EpiMla {
    bf16_t* O; int hw; const float* sqp; int s0, ns; float invn;
    __device__ __forceinline__ bool keep(const Unit&) const { return false; }
    __device__ __forceinline__ void operator()(f32x4 (&acc)[2][2][4][2], const Unit& u, int wr, int wc, int fr, int fq) const {
        const int row0 = u.pm * BM + wr * 64 + fr, col0 = u.pn * BM + wc * 32 + 8 * fq;
        const int c0 = col0, c1 = col0 + HALF; const int h0 = c0 / hw, h1 = c1 / hw;
        bf16_t* p0 = O + (size_t)h0 * T * hw + (c0 - h0 * hw); bf16_t* p1 = O + (size_t)h1 * T * hw + (c1 - h1 * hw);
#pragma unroll
        for (int ai = 0; ai < 2; ++ai)
#pragma unroll
            for (int m = 0; m < 4; ++m) { const int row = row0 + ai * HALF + m * 16; float ssum = 0.f; for (int q = 0; q < ns; ++q) ssum += sqp[(size_t)row * 12 + s0 + q]; const float rs = 1.0f / sqrtf(ssum * invn + EPS);
                store8(p0 + (size_t)row * hw, acc[ai][0][m][0] * rs, acc[ai][0][m][1] * rs); store8(p1 + (size_t)row * hw, acc[ai][1][m][0] * rs, acc[ai][1][m][1] * rs);
                asm volatile("" ::: "memory"); }
    }
};
struct EpiGate {
    bf16_t* R; const float* bgate; float wscale;
    __device__ __forceinline__ bool keep(const Unit&) const { return false; }
    __device__ __forceinline__ void operator()(f32x4 (&acc)[2][2][4][2], const Unit& u, int wr, int wc, int fr, int fq) const {
        const int row0 = u.pm * BM + wr * 64 + fr, ch = u.pn * 64 + wc * 16 + 4 * fq;
#pragma unroll
        for (int ai = 0; ai < 2; ++ai)
#pragma unroll
            for (int m = 0; m < 4; ++m) { bf16_t* rp = R + (size_t)(row0 + ai * HALF + m * 16) * 8192 + ch; float r[4][4];
                const f32x4 b0 = *(const f32x4*)(bgate + ch), b1 = *(const f32x4*)(bgate + 2048 + ch), b2 = *(const f32x4*)(bgate + 4096 + ch), b3 = *(const f32x4*)(bgate + 6144 + ch);
#pragma unroll
                for (int e = 0; e < 4; ++e) {
                    const float d0 = 1.0f + __builtin_amdgcn_exp2f(-LOG2E * (acc[ai][0][m][0][e] * wscale + b0[e])), d1 = 1.0f + __builtin_amdgcn_exp2f(-LOG2E * (acc[ai][0][m][1][e] * wscale + b1[e]));
                    const float d2 = 1.0f + __builtin_amdgcn_exp2f(-LOG2E * (acc[ai][1][m][0][e] * wscale + b2[e])), d3 = 1.0f + __builtin_amdgcn_exp2f(-LOG2E * (acc[ai][1][m][1][e] * wscale + b3[e]));
                    r[0][e] = d1 * __builtin_amdgcn_rcpf(d0); r[1][e] = d2 * __builtin_amdgcn_rcpf(d1); r[2][e] = d3 * __builtin_amdgcn_rcpf(d2); r[3][e] = __builtin_amdgcn_rcpf(d3); }
#pragma unroll
                for (int i = 0; i < 4; ++i) { u32x2 w; w.x = pk2(r[i][0], r[i][1]); w.y = pk2(r[i][2], r[i][3]); *(u32x2*)(rp + i * 2048) = w; }
                asm volatile("" ::: "memory"); }
    }
};
struct EpiMerge {
    const bf16_t* GT; bf16_t* O;
    __device__ __forceinline__ bool keep(const Unit& u) const { return u.aux != 3; }
    __device__ __forceinline__ void operator()(f32x4 (&acc)[2][2][4][2], const Unit& u, int wr, int wc, int fr, int fq) const {
        const int row0 = u.pm * BM + wr * 64 + fr, col0 = u.pn * BM + wc * 32 + 8 * fq; const int br = u.aux;
        u32x4 gr[2][4][2];
#pragma unroll
        for (int ai = 0; ai < 2; ++ai)
#pragma unroll
            for (int m = 0; m < 4; ++m)
#pragma unroll
                for (int bj = 0; bj < 2; ++bj) gr[ai][m][bj] = *(const u32x4*)(GT + (size_t)(row0 + ai * HALF + m * 16) * 8192 + br * 2048 + col0 + bj * HALF);
#pragma unroll
        for (int ai = 0; ai < 2; ++ai)
#pragma unroll
            for (int m = 0; m < 4; ++m)
#pragma unroll
                for (int bj = 0; bj < 2; ++bj) { const u32x4 g0 = gr[ai][m][bj];
                    acc[ai][bj][m][0][0] *= bflo(g0.x); acc[ai][bj][m][0][1] *= bfhi(g0.x); acc[ai][bj][m][0][2] *= bflo(g0.y); acc[ai][bj][m][0][3] *= bfhi(g0.y);
                    acc[ai][bj][m][1][0] *= bflo(g0.z); acc[ai][bj][m][1][1] *= bfhi(g0.z); acc[ai][bj][m][1][2] *= bflo(g0.w); acc[ai][bj][m][1][3] *= bfhi(g0.w);
                    if (br == 3) store8(O + (size_t)(row0 + ai * HALF + m * 16) * 2048 + col0 + bj * HALF, acc[ai][bj][m][0], acc[ai][bj][m][1]); }
    }
};
struct EpiOut {
    const float* hin32; const bf16_t* hin16; bf16_t* hout;
    __device__ __forceinline__ bool keep(const Unit&) const { return false; }
    __device__ __forceinline__ void operator()(f32x4 (&acc)[2][2][4][2], const Unit& u, int wr, int wc, int fr, int fq) const {
        const int row0 = u.pm * BM + wr * 64 + fr, col0 = u.pn * BM + wc * 32 + 8 * fq;
#pragma unroll
        for (int ai = 0; ai < 2; ++ai)
#pragma unroll
            for (int m = 0; m < 4; ++m) { const size_t off = (size_t)(row0 + ai * HALF + m * 16) * 2048 + col0;
#pragma unroll
                for (int bj = 0; bj < 2; ++bj) { f32x4 b0, b1;
                    if (hin32) { b0 = *(const f32x4*)(hin32 + off + bj * HALF); b1 = *(const f32x4*)(hin32 + off + bj * HALF + 4); }
                    else { const u32x4 w = *(const u32x4*)(hin16 + off + bj * HALF); b0 = (f32x4){bflo(w.x), bfhi(w.x), bflo(w.y), bfhi(w.y)}; b1 = (f32x4){bflo(w.z), bfhi(w.z), bflo(w.w), bfhi(w.w)}; }
                    store8(hout + off + bj * HALF, b0 + acc[ai][bj][m][0], b1 + acc[ai][bj][m][1]); } }
    }
};
struct EpiGateUp {
    unsigned char* H;
    __device__ __forceinline__ bool keep(const Unit&) const { return false; }
    __device__ __forceinline__ void operator()(f32x4 (&acc)[2][2][4][2], const Unit& u, int wr, int wc, int fr, int fq) const {
        const int row0 = u.pm * BM + wr * 64 + fr, col0 = u.pn * 128 + wc * 32 + 8 * fq;
#pragma unroll
        for (int ai = 0; ai < 2; ++ai)
#pragma unroll
            for (int m = 0; m < 4; ++m) { f32x4 v[2];
#pragma unroll
                for (int n = 0; n < 2; ++n)
#pragma unroll
                    for (int e = 0; e < 4; ++e) { const float gte = acc[ai][0][m][n][e] * (1.0f / 64.0f), up = acc[ai][1][m][n][e] * (8.0f / 64.0f); v[n][e] = gte * __builtin_amdgcn_rcpf(1.0f + __builtin_amdgcn_exp2f(-LOG2E * gte)) * up; }
                u32x2 w; w.x = pk4_fp8(v[0][0], v[0][1], v[0][2], v[0][3]); w.y = pk4_fp8(v[1][0], v[1][1], v[1][2], v[1][3]);
                *(u32x2*)(H + (size_t)(row0 + ai * HALF + m * 16) * FF + col0) = w; }
    }
};
struct EpiDown {
    bf16_t* Y; const float* gv;
    __device__ __forceinline__ bool keep(const Unit&) const { return false; }
    __device__ __forceinline__ void operator()(f32x4 (&acc)[2][2][4][2], const Unit& u, int wr, int wc, int fr, int fq) const {
        const int row0 = u.pm * BM + wr * 64 + fr, col0 = u.pn * BM + wc * 32 + 8 * fq;
#pragma unroll
        for (int ai = 0; ai < 2; ++ai)
#pragma unroll
            for (int m = 0; m < 4; ++m) { const int row = row0 + ai * HALF + m * 16; const float gs = gv[row] * (1.0f / 256.0f); bf16_t* rowp = Y + (size_t)row * 2048 + col0;
#pragma unroll
                for (int bj = 0; bj < 2; ++bj) store8(rowp + bj * HALF, acc[ai][bj][m][0] * gs, acc[ai][bj][m][1] * gs); }
    }
};
}

struct Args { const float* in[19]; float* out; unsigned char* ws; int ph_lo, ph_hi; };
enum { I_X = 0, I_WIN, I_BGATE, I_GATTN, I_GFFN, I_GMQ, I_GMKV, I_WUQ, I_WUKV, I_GCQ, I_GCK, I_SINK, I_WBR, I_WOUT, I_WROUTER, I_WEG, I_WEU, I_WED, I_GFINAL };

typedef const __attribute__((address_space(4))) unsigned char* kargp_t;
#define KARG_IN(kp, i) (*(const float* const __attribute__((address_space(4)))*)((kp) + 8 * (i)))
#define KARG_OUT(kp) (*(float* const __attribute__((address_space(4)))*)((kp) + 152))
#define KARG_WS(kp) (*(unsigned char* const __attribute__((address_space(4)))*)((kp) + 160))
#define KARG_LO(kp) (*(const int __attribute__((address_space(4)))*)((kp) + 168))
#define KARG_HI(kp) (*(const int __attribute__((address_space(4)))*)((kp) + 172))
struct Frame {
    LAS unsigned char* lds; gu32* ctl; unsigned char* ws; kargp_t kp;
    int tid, lane, wave, bid, G;
};

__device__ __forceinline__ void conv_item(const float* src, int N, bf16_t* dst, int ld, int k0, int n0, int rowbase, const float* g, LAS float* scr, int lane) {
    f32x4 v[16];
    const int kr = lane >> 3, nc = 4 * (lane & 7);
#pragma unroll
    for (int i = 0; i < 16; ++i) v[i] = *(const f32x4*)(src + (size_t)(k0 + kr + 8 * i) * N + n0 + nc);
    if (g) {
#pragma unroll
        for (int i = 0; i < 16; ++i) v[i] = v[i] * g[k0 + kr + 8 * i];
    }
#pragma unroll
    for (int i = 0; i < 16; ++i) { LAS float* p = scr + (kr + 8 * i) * 33 + nc; p[0] = v[i][0]; p[1] = v[i][1]; p[2] = v[i][2]; p[3] = v[i][3]; }
    LDS_WAIT(); asm volatile("" ::: "memory");
    const int c = lane & 15;
#pragma unroll
    for (int j = 0; j < 8; ++j) { const int n = (lane >> 4) + 4 * j; const LAS float* s = scr + (8 * c) * 33 + n;
        u32x4 o; o.x = pk2(s[0], s[33]); o.y = pk2(s[2 * 33], s[3 * 33]); o.z = pk2(s[4 * 33], s[5 * 33]); o.w = pk2(s[6 * 33], s[7 * 33]);
        *(u32x4*)(dst + (size_t)(rowbase + n) * ld + k0 + 8 * c) = o; }
    LDS_WAIT(); asm volatile("" ::: "memory");
}
__device__ __forceinline__ void conv_item_gate(const float* src, int N, unsigned char* dst, int k0, int n0, int br, int ch0, LAS float* scr, int lane, int ldb = 2048, float sc = 64.f) {
    f32x4 v[16];
    const int kr = lane >> 3, nc = 4 * (lane & 7);
#pragma unroll
    for (int i = 0; i < 16; ++i) v[i] = *(const f32x4*)(src + (size_t)(k0 + kr + 8 * i) * N + n0 + nc);
#pragma unroll
    for (int i = 0; i < 16; ++i) { LAS float* p = scr + (kr + 8 * i) * 33 + nc; p[0] = v[i][0]; p[1] = v[i][1]; p[2] = v[i][2]; p[3] = v[i][3]; }
    LDS_WAIT(); asm volatile("" ::: "memory");
    const int c16 = lane & 15;
#pragma unroll
    for (int j = 0; j < 8; ++j) { const int n = (lane >> 4) + 4 * j; const LAS float* s = scr + (8 * c16) * 33 + n;
        const int chn = ch0 + n, c = chn & 63; const int row = (br < 0) ? chn : 7168 + (chn >> 6) * 256 + 128 * (br >> 1) + 32 * (c >> 4) + 8 * ((c >> 2) & 3) + 4 * (br & 1) + (c & 3);
        u32x2 o; o.x = pk4_fp8(s[0] * sc, s[33] * sc, s[2 * 33] * sc, s[3 * 33] * sc); o.y = pk4_fp8(s[4 * 33] * sc, s[5 * 33] * sc, s[6 * 33] * sc, s[7 * 33] * sc);
        *(u32x2*)(dst + (size_t)row * ldb + k0 + 8 * c16) = o; }
    LDS_WAIT(); asm volatile("" ::: "memory");
}
__device__ __forceinline__ int win_rowmap(int n) {
    if (n < 4608) return n;
    if (n < 5408) return 6144 + (n - 4608);
    if (n < 6176) return 4608 + (n - 5408);
    if (n < 6944) return 5376 + (n - 6176);
    return 7168 + (n - 6944);
}
__device__ __forceinline__ void conv_layer(const Frame& F, int l) {
    LAS float* scr = (LAS float*)(F.lds + F.wave * 16896);
    const int gw = F.bid * NWAVES + F.wave, NGW = F.G * NWAVES, lane = F.lane;
    bf16_t* WIN = (bf16_t*)(F.ws + WS_WIN); bf16_t* WUQ = (bf16_t*)(F.ws + WS_WUQ); bf16_t* WUKV = (bf16_t*)(F.ws + WS_WUKV); bf16_t* WBR = (bf16_t*)(F.ws + WS_WBR);
    bf16_t* WOUT = (bf16_t*)(F.ws + WS_WOUT); bf16_t* WGU = (bf16_t*)(F.ws + WS_WGU); bf16_t* WD = (bf16_t*)(F.ws + WS_WD);
    constexpr int I0 = 16 * 473, I1 = 4 * 24, I2 = 2 * 32, I3 = 4 * 4 * 64, I4 = 16 * 64, I5 = 16 * 16 * 32, I6 = I5, I7 = 16 * 8 * 64;
    constexpr int NIT = I0 + I1 + I2 + I3 + I4 + I5 + I6 + I7;
    for (int it = gw; it < NIT; it += NGW) {
        int r = it;
        if (r < I0) { const int kb = r / 473, nb = r % 473, n0 = nb * 32;
            if (n0 < 6944) { if (PROJ_BF16) conv_item(KARG_IN(F.kp, I_WIN) + (size_t)l * 2048 * N_IN, N_IN, (bf16_t*)(F.ws + WS_WIN + 30 * MiB), 2048, kb * 128, n0, win_rowmap(n0), nullptr, scr, lane);
                             else conv_item_gate(KARG_IN(F.kp, I_WIN) + (size_t)l * 2048 * N_IN, N_IN, (unsigned char*)(F.ws + WS_W8), kb * 128, n0, -1, win_rowmap(n0), scr, lane); }
            else { const int gc = n0 - 6944; conv_item_gate(KARG_IN(F.kp, I_WIN) + (size_t)l * 2048 * N_IN, N_IN, (unsigned char*)(F.ws + WS_W8), kb * 128, n0, gc >> 11, gc & 2047, scr, lane); }
            continue; } r -= I0;
        if (r < I1) { const int kb = r / 24, nb = r % 24; conv_item(KARG_IN(F.kp, I_WUQ) + (size_t)l * 512 * 768, 768, WUQ, 512, kb * 128, nb * 32, nb * 32, KARG_IN(F.kp, I_GMQ) + l * 512, scr, lane); continue; } r -= I1;
        if (r < I2) { const int kb = r / 32, nb = r % 32; conv_item(KARG_IN(F.kp, I_WUKV) + (size_t)l * 256 * 1024, 1024, WUKV, 256, kb * 128, nb * 32, nb * 32, KARG_IN(F.kp, I_GMKV) + l * 256, scr, lane); continue; } r -= I2;
        if (r < I3) { const int br = r / 256, q = r % 256, kb = q / 64, nb = q % 64; conv_item(KARG_IN(F.kp, I_WBR) + (size_t)(l * 4 + br) * 512 * 2048, 2048, WBR + br * 512, 2048, kb * 128, nb * 32, nb * 32, nullptr, scr, lane); continue; } r -= I3;
        if (r < I4) { const int kb = r / 64, nb = r % 64; conv_item(KARG_IN(F.kp, I_WOUT) + (size_t)l * 2048 * 2048, 2048, WOUT, 2048, kb * 128, nb * 32, nb * 32, nullptr, scr, lane); continue; } r -= I4;
        if (r < I5 + I6) { const int up = r >= I5; if (up) r -= I5; const int e = r / 512, q = r % 512, kb = q / 32, nb = q % 32, f0 = nb * 32;
            conv_item_gate(KARG_IN(F.kp, up ? I_WEU : I_WEG) + (size_t)(l * 16 + e) * 2048 * 1024, 1024, (unsigned char*)WGU + (size_t)e * 2048 * 2048, kb * 128, f0, -1, (f0 >> 7) * 256 + up * 128 + (f0 & 127), scr, lane, 2048, 64.f); continue; } r -= I5 + I6;
        { const int e = r / 512, q = r % 512, kb = q / 64, nb = q % 64; conv_item_gate(KARG_IN(F.kp, I_WED) + (size_t)(l * 16 + e) * 1024 * 2048, 2048, (unsigned char*)WD + (size_t)e * 2048 * 1024, kb * 128, nb * 32, -1, nb * 32, scr, lane, 1024, 32.f); }
    }
    for (int i = gw * 64 + lane; i < 224 * 2048 / 16; i += NGW * 64) ((u32x4*)(F.ws + WS_W8 + (size_t)6944 * 2048))[i] = (u32x4){0u, 0u, 0u, 0u};
    if (PROJ_BF16) for (int i = gw * 64 + lane; i < 224 * 2048 / 8; i += NGW * 64) ((u32x4*)(F.ws + WS_WIN + 30 * MiB + (size_t)6944 * 4096))[i] = (u32x4){0u, 0u, 0u, 0u};
    if (l == 0) {
        f32x2* rt = (f32x2*)(F.ws + WS_ROPE);
        for (int i = gw * 64 + lane; i < 2048 * 16; i += NGW * 64) { const int pos = i >> 4, k = i & 15; const float fr = exp2f(-(float)k * (13.287712379549449f / 16.0f)); const float ang = (float)pos * fr; rt[i] = (f32x2){cosf(ang), sinf(ang)}; }
    }
}

template <int MODE>
__device__ __forceinline__ void norm_rows(const Frame& F, const float* hin, float* hout, const float* g, bf16_t* xn) {
    bf16_t* H = (bf16_t*)(F.ws + WS_H);
#define NR_LOAD(dst, row, j) do { if (MODE == 0) dst = *(const f32x4*)(hin + (size_t)(row) * DM + 4 * (lane + 64 * (j))); else { const u32x2 w_ = *(const u32x2*)(H + (size_t)(row) * DM + 4 * (lane + 64 * (j))); dst = (f32x4){bflo(w_.x), bfhi(w_.x), bflo(w_.y), bfhi(w_.y)}; } } while (0)
    const int gw = F.bid * NWAVES + F.wave, NGW = F.G * NWAVES, lane = F.lane;
    const bf16_t* YE = (const bf16_t*)(F.ws + WS_YE); const short* SEL = (const short*)(F.ws + WS_SEL); unsigned char* xn8 = F.ws + WS_XN8;
    f32x4 gv[8];
#pragma unroll
    for (int j = 0; j < 8; ++j) gv[j] = *(const f32x4*)(g + 4 * (lane + 64 * j));
    f32x4 vn[8]; int seln = -1;
    if (gw < T) {
#pragma unroll
        for (int j = 0; j < 8; ++j) NR_LOAD(vn[j], gw, j);
        if (MODE != 0) seln = (lane < NE) ? (int)SEL[(size_t)gw * NE + lane] : -1;
    }
    for (int m = gw; m < T; m += NGW) {
        f32x4 v[8]; const int selv = seln;
#pragma unroll
        for (int j = 0; j < 8; ++j) v[j] = vn[j];
        if (m + NGW < T) {
#pragma unroll
            for (int j = 0; j < 8; ++j) NR_LOAD(vn[j], m + NGW, j);
            if (MODE != 0) seln = (lane < NE) ? (int)SEL[(size_t)(m + NGW) * NE + lane] : -1;
        }
        if (MODE != 0) {
            const int b = m >> 11;
            unsigned mask = (unsigned)__ballot(selv >= 0);
            while (mask) {
                const int e0 = __builtin_ctz(mask); mask &= mask - 1u; const bool two = mask != 0u; const int e1 = two ? __builtin_ctz(mask) : e0; if (two) mask &= mask - 1u;
                const int s0 = __builtin_amdgcn_readlane(selv, e0), s1 = __builtin_amdgcn_readlane(selv, e1);
                const bf16_t* y0 = YE + (size_t)((b * NE + e0) * CAP + s0) * DM; const bf16_t* y1 = YE + (size_t)((b * NE + e1) * CAP + s1) * DM;
                u32x2 w0[8], w1[8];
#pragma unroll
                for (int j = 0; j < 8; ++j) { w0[j] = *(const u32x2*)(y0 + 4 * (lane + 64 * j)); w1[j] = *(const u32x2*)(y1 + 4 * (lane + 64 * j)); }
                const float f1 = two ? 1.0f : 0.0f;
#pragma unroll
                for (int j = 0; j < 8; ++j) { v[j][0] += bflo(w0[j].x) + f1 * bflo(w1[j].x); v[j][1] += bfhi(w0[j].x) + f1 * bfhi(w1[j].x); v[j][2] += bflo(w0[j].y) + f1 * bflo(w1[j].y); v[j][3] += bfhi(w0[j].y) + f1 * bfhi(w1[j].y); }
            }
            if (MODE == 1) {
#pragma unroll
                for (int j = 0; j < 8; ++j) { u32x2 w; w.x = pk2(v[j][0], v[j][1]); w.y = pk2(v[j][2], v[j][3]); *(u32x2*)(H + (size_t)m * DM + 4 * (lane + 64 * j)) = w; }
            }
        }
        float ss = 0.f;
#pragma unroll
        for (int j = 0; j < 8; ++j) ss += (v[j][0] * v[j][0] + v[j][1] * v[j][1]) + (v[j][2] * v[j][2] + v[j][3] * v[j][3]);
        const float rs = 1.0f / sqrtf(wave_sum(ss) * (1.0f / DM) + EPS);
        if (MODE == 2) {
#pragma unroll
            for (int j = 0; j < 8; ++j) *(f32x4*)(hout + (size_t)m * DM + 4 * (lane + 64 * j)) = v[j] * rs * gv[j];
        } else {
#pragma unroll
            for (int j = 0; j < 8; ++j) { const f32x4 o = v[j] * rs * gv[j]; *(unsigned*)(xn8 + (size_t)m * DM + 4 * (lane + 64 * j)) = pk4_fp8(o[0], o[1], o[2], o[3]);
                if (PROJ_BF16) { u32x2 w; w.x = pk2(o[0], o[1]); w.y = pk2(o[2], o[3]); *(u32x2*)(xn + (size_t)m * DM + 4 * (lane + 64 * j)) = w; } }
        }
    }
}
__device__ __forceinline__ void norm2_router(const Frame& F, const bf16_t* h, const float* g, const float* wr, unsigned char* xn, float* probs) {
#define N2_LOAD(dst, row, j) do { const u32x2 w_ = *(const u32x2*)(h + (size_t)(row) * DM + 4 * (lane + 64 * (j))); dst = (f32x4){bflo(w_.x), bfhi(w_.x), bflo(w_.y), bfhi(w_.y)}; } while (0)
    LAS float* wt = (LAS float*)F.lds;
    for (int i = F.tid; i < DM * NE / 4; i += NTHR) { const f32x4 w = *(const f32x4*)(wr + 4 * i); const int col = i >> 2, e0 = (i & 3) * 4;
        wt[(e0 + 0) * DM + col] = w[0]; wt[(e0 + 1) * DM + col] = w[1]; wt[(e0 + 2) * DM + col] = w[2]; wt[(e0 + 3) * DM + col] = w[3]; }
    __syncthreads();
    const int gw = F.bid * NWAVES + F.wave, NGW = F.G * NWAVES, lane = F.lane;
    f32x4 n0[8], n1[8];
    if (2 * gw < T) {
#pragma unroll
        for (int j = 0; j < 8; ++j) { N2_LOAD(n0[j], 2 * gw, j); N2_LOAD(n1[j], 2 * gw + 1, j); }
    }
    for (int m = 2 * gw; m < T; m += 2 * NGW) {
        f32x4 v0[8], v1[8]; float ss0 = 0.f, ss1 = 0.f;
#pragma unroll
        for (int j = 0; j < 8; ++j) { v0[j] = n0[j]; v1[j] = n1[j]; }
        if (m + 2 * NGW < T) {
#pragma unroll
            for (int j = 0; j < 8; ++j) { N2_LOAD(n0[j], m + 2 * NGW, j); N2_LOAD(n1[j], m + 2 * NGW + 1, j); }
        }
#pragma unroll
        for (int j = 0; j < 8; ++j) { ss0 += (v0[j][0] * v0[j][0] + v0[j][1] * v0[j][1]) + (v0[j][2] * v0[j][2] + v0[j][3] * v0[j][3]); ss1 += (v1[j][0] * v1[j][0] + v1[j][1] * v1[j][1]) + (v1[j][2] * v1[j][2] + v1[j][3] * v1[j][3]); }
        const float rs0 = 1.0f / sqrtf(wave_sum(ss0) * (1.0f / DM) + EPS), rs1 = 1.0f / sqrtf(wave_sum(ss1) * (1.0f / DM) + EPS);
#pragma unroll
        for (int j = 0; j < 8; ++j) { const f32x4 gj = *(const f32x4*)(g + 4 * (lane + 64 * j)); v0[j] = v0[j] * rs0 * gj; v1[j] = v1[j] * rs1 * gj;
            *(unsigned*)(xn + (size_t)m * DM + 4 * (lane + 64 * j)) = pk4_fp8(v0[j][0], v0[j][1], v0[j][2], v0[j][3]);
            *(unsigned*)(xn + (size_t)(m + 1) * DM + 4 * (lane + 64 * j)) = pk4_fp8(v1[j][0], v1[j][1], v1[j][2], v1[j][3]); }
        float s0[NE], s1[NE];
#pragma unroll
        for (int e = 0; e < NE; ++e) { f32x2 a0 = {0.f, 0.f}, a1 = {0.f, 0.f};
#pragma unroll
            for (int j = 0; j < 8; ++j) { const f32x4 w = *(const LAS f32x4*)(wt + e * DM + 4 * (lane + 64 * j)); const f32x2 wl = {w[0], w[1]}, wh = {w[2], w[3]};
                a0 = __builtin_elementwise_fma((f32x2){v0[j][0], v0[j][1]}, wl, a0); a0 = __builtin_elementwise_fma((f32x2){v0[j][2], v0[j][3]}, wh, a0);
                a1 = __builtin_elementwise_fma((f32x2){v1[j][0], v1[j][1]}, wl, a1); a1 = __builtin_elementwise_fma((f32x2){v1[j][2], v1[j][3]}, wh, a1); }
            s0[e] = a0[0] + a0[1]; s1[e] = a1[0] + a1[1]; asm volatile("" ::: "memory"); }
        const bool up = lane >= 32;
        float r16[16];
#pragma unroll
        for (int e = 0; e < 16; ++e) { const float keep = up ? s1[e] : s0[e], send = up ? s0[e] : s1[e]; r16[e] = keep + __shfl_xor(send, 32); }
        float r8[8]; { const bool b = (lane & 16) != 0;
#pragma unroll
            for (int e = 0; e < 8; ++e) { const float keep = b ? r16[8 + e] : r16[e], send = b ? r16[e] : r16[8 + e]; r8[e] = keep + __shfl_xor(send, 16); } }
        float r4[4]; { const bool b = (lane & 8) != 0;
#pragma unroll
            for (int e = 0; e < 4; ++e) { const float keep = b ? r8[4 + e] : r8[e], send = b ? r8[e] : r8[4 + e]; r4[e] = keep + __shfl_xor(send, 8); } }
        float r2[2]; { const bool b = (lane & 4) != 0;
#pragma unroll
            for (int e = 0; e < 2; ++e) { const float keep = b ? r4[2 + e] : r4[e], send = b ? r4[e] : r4[2 + e]; r2[e] = keep + __shfl_xor(send, 4); } }
        float lg; { const bool b = (lane & 2) != 0; const float keep = b ? r2[1] : r2[0], send = b ? r2[0] : r2[1]; lg = keep + __shfl_xor(send, 2); }
        lg += __shfl_xor(lg, 1);
        float mx = lg;
#pragma unroll
        for (int o = 2; o < 32; o <<= 1) mx = fmaxf(mx, __shfl_xor(mx, o));
        const float ex = __expf(lg - mx); float den = ex;
#pragma unroll
        for (int o = 2; o < 32; o <<= 1) den += __shfl_xor(den, o);
        if ((lane & 1) == 0) probs[(size_t)(m + (lane >> 5)) * NE + ((lane >> 1) & 15)] = ex / den;
    }
    __syncthreads();
}

__device__ __forceinline__ void prep_rows(const Frame& F, const float* gck) {
    const bf16_t* PC = (const bf16_t*)(F.ws + WS_PC); const bf16_t* PB = (const bf16_t*)(F.ws + WS_PB);
    bf16_t* KC = (bf16_t*)(F.ws + WS_KC); bf16_t* KPE = (bf16_t*)(F.ws + WS_KPE); const f32x2* rt = (const f32x2*)(F.ws + WS_ROPE);
    const int gt = F.bid * NTHR + F.tid, NGT = F.G * NTHR;
    for (int w = gt; w < T * 2; w += NGT) {
        const int hh = w & 1, t = w >> 1, pos = t & (S - 1);
        const u32x4* src = (const u32x4*)(PC + ((size_t)(8 + hh) * T + t) * 64);
        u32x4 q[8];
#pragma unroll
        for (int c = 0; c < 8; ++c) q[c] = src[c];
        float x[64];
#pragma unroll
        for (int c = 0; c < 8; ++c) { x[8 * c + 0] = bflo(q[c].x); x[8 * c + 1] = bfhi(q[c].x); x[8 * c + 2] = bflo(q[c].y); x[8 * c + 3] = bfhi(q[c].y); x[8 * c + 4] = bflo(q[c].z); x[8 * c + 5] = bfhi(q[c].z); x[8 * c + 6] = bflo(q[c].w); x[8 * c + 7] = bfhi(q[c].w); }
        float ss = 0.f;
#pragma unroll
        for (int i = 0; i < 64; ++i) ss += x[i] * x[i];
        const float rs = 1.0f / sqrtf(ss * (1.0f / 64.0f) + EPS);
#pragma unroll
        for (int i = 0; i < 64; ++i) x[i] *= rs * gck[i];
        const f32x2* rr = rt + (pos >> 6) * 16; const f32x2* rc = rt + (pos & 63) * 16;
#pragma unroll
        for (int i = 0; i < 16; ++i) { const f32x2 c0 = rr[i], c1 = rc[i]; const float a0 = x[i], a1 = x[16 + i], b0 = x[32 + i], b1 = x[48 + i];
            x[i] = a0 * c0.x - a1 * c0.y; x[16 + i] = a0 * c0.y + a1 * c0.x; x[32 + i] = b0 * c1.x - b1 * c1.y; x[48 + i] = b0 * c1.y + b1 * c1.x; }
        u32x4* d = (u32x4*)(KC + ((size_t)hh * T + t) * 64);
#pragma unroll
        for (int c = 0; c < 8; ++c) { u32x4 o; o.x = pk2(x[8 * c], x[8 * c + 1]); o.y = pk2(x[8 * c + 2], x[8 * c + 3]); o.z = pk2(x[8 * c + 4], x[8 * c + 5]); o.w = pk2(x[8 * c + 6], x[8 * c + 7]); d[c] = o; }
    }
    for (int t = gt; t < T; t += NGT) {
        const int pos = t & (S - 1);
        const u32x4* src = (const u32x4*)(PB + (size_t)t * 1024 + 768);
        u32x4 q[4];
#pragma unroll
        for (int c = 0; c < 4; ++c) q[c] = src[c];
        float x[32];
#pragma unroll
        for (int c = 0; c < 4; ++c) { x[8 * c + 0] = bflo(q[c].x); x[8 * c + 1] = bfhi(q[c].x); x[8 * c + 2] = bflo(q[c].y); x[8 * c + 3] = bfhi(q[c].y); x[8 * c + 4] = bflo(q[c].z); x[8 * c + 5] = bfhi(q[c].z); x[8 * c + 6] = bflo(q[c].w); x[8 * c + 7] = bfhi(q[c].w); }
        const f32x2* rp = rt + pos * 16;
#pragma unroll
        for (int i = 0; i < 16; ++i) { const f32x2 cs = rp[i]; const float a0 = x[i], a1 = x[16 + i]; x[i] = a0 * cs.x - a1 * cs.y; x[16 + i] = a0 * cs.y + a1 * cs.x; }
        u32x4* d = (u32x4*)(KPE + (size_t)t * 32);
#pragma unroll
        for (int c = 0; c < 4; ++c) { u32x4 o; o.x = pk2(x[8 * c], x[8 * c + 1]); o.y = pk2(x[8 * c + 2], x[8 * c + 3]); o.z = pk2(x[8 * c + 4], x[8 * c + 5]); o.w = pk2(x[8 * c + 6], x[8 * c + 7]); d[c] = o; }
    }
}

struct AttnArgs {
    const bf16_t* Q; int qp;
    const bf16_t* K; int kp;
    const bf16_t* K2;
    const bf16_t* V; int vp;
    bf16_t* O; int op;
    float* lse;
    int L0;
    int dshift, ldshift;
    int W;
    float c2, slope2, sink2;
    const float* gq;
    const f32x2* rope;
};
__device__ __forceinline__ int tok_of(int L, int dshift, int ldshift) { const int b = L >> 11, w = L & 2047; return (b << 11) + ((w & ((1 << ldshift) - 1)) << dshift) + (w >> ldshift); }
__device__ __forceinline__ int crow(int r, int hi) { return (r & 3) + 8 * (r >> 2) + 4 * hi; }
__device__ __forceinline__ s16x4 vtr(const LAS unsigned char* p) { return __builtin_bit_cast(s16x4, __builtin_amdgcn_ds_read_tr16_b64_v4i16((LAS s16x4*)p)); }

__device__ __forceinline__ void glds16(const void* gsrc, unsigned lds_dst) { unsigned keep;
    asm volatile("s_mov_b32 %0, m0\n\ts_mov_b32 m0, %2\n\ts_nop 0\n\tglobal_load_lds_dwordx4 %1, off\n\ts_mov_b32 m0, %0" : "=&s"(keep) : "v"(gsrc), "s"(lds_dst) : "memory"); }
template <int DQ, bool BANDED, bool SINK, bool LSE_OUT, int QMODE>
__device__ __forceinline__ void attn_unit(const AttnArgs& a, LAS unsigned char* lds) {
    constexpr int NS = DQ / 16, KB = DQ * 128, SLOT = KB + 8192;
    int tid_ = threadIdx.x; asm volatile("" : "+v"(tid_));
    const int tid = tid_, lane = tid & 63, r32 = lane & 31, hi = lane >> 5; const int wid = __builtin_amdgcn_readfirstlane(tid >> 6);
    const int Ld = 1 << a.ldshift;
    const int Lq0 = a.L0 + 32 * wid, Lq = Lq0 + r32;
    int t0, t1, wlo, whi, llo, lhi, wfull_lo = 0, wfull_hi = 0;
    if (BANDED) {
        const int us = a.L0 & ~(Ld - 1), ue = ((a.L0 + 255) & ~(Ld - 1)) + Ld;
        const int klo = max(a.L0 - a.W, us), khi = min(a.L0 + 256 + a.W, ue);
        t0 = klo >> 6; t1 = (khi + 63) >> 6;
        const int zs = Lq0 & ~(Ld - 1), ze = zs + Ld;
        wlo = max(Lq0 - a.W, zs); whi = min(Lq0 + 32 + a.W, ze);
        llo = max(Lq - a.W, zs); lhi = min(Lq + a.W + 1, ze);
        wfull_lo = max(Lq0 + 31 - a.W, zs); wfull_hi = min(Lq0 + a.W + 1, ze);
    } else { t0 = (a.L0 & ~2047) >> 6; t1 = t0 + 32; wlo = 0; whi = 0; llo = 0; lhi = 0; }
    const float flo = (float)(llo - Lq), fhi = (float)(lhi - 1 - Lq);
    const int vkey = 16 * (wid & 3) + (lane >> 2), vcol = 32 * (wid >> 2) + 8 * (lane & 3);
    const bool rope_wave = (DQ == 96) && (wid < 4);
    const unsigned lds0 = (unsigned)(size_t)lds;
#define ATT_DMA(t, slot) do { const int Lk_ = min(max((t) * 64 + lane, 0), T - 1), Lv_ = min(max((t) * 64 + vkey, 0), T - 1); \
        const int tk_ = Lk_, tv_ = Lv_; const unsigned s_ = lds0 + (unsigned)((slot) * SLOT);        \
        glds16(a.K + (size_t)tk_ * a.kp + 8 * wid, (unsigned)__builtin_amdgcn_readfirstlane(s_ + wid * 1024)); \
        if (rope_wave) glds16(a.K2 + (size_t)tk_ * 32 + 8 * wid, (unsigned)__builtin_amdgcn_readfirstlane(s_ + (8 + wid) * 1024)); \
        glds16(a.V + (size_t)tv_ * a.vp + vcol, (unsigned)__builtin_amdgcn_readfirstlane(s_ + KB + wid * 1024)); } while (0)
#define ATT_WAIT(nahead) do { if (rope_wave) { if ((nahead) >= 2) asm volatile("s_waitcnt vmcnt(6)" ::: "memory"); else if ((nahead) == 1) asm volatile("s_waitcnt vmcnt(3)" ::: "memory"); else asm volatile("s_waitcnt vmcnt(0)" ::: "memory"); } \
        else { if ((nahead) >= 2) asm volatile("s_waitcnt vmcnt(4)" ::: "memory"); else if ((nahead) == 1) asm volatile("s_waitcnt vmcnt(2)" ::: "memory"); else asm volatile("s_waitcnt vmcnt(0)" ::: "memory"); } } while (0)
    if (BANDED) { for (int t = t0; t < t1; ++t) ATT_DMA(t, t - t0); }
    else { ATT_DMA(t0, 0); if (t0 + 1 < t1) ATT_DMA(t0 + 1, 1); if (t0 + 2 < t1) ATT_DMA(t0 + 2, 2); }
    const int qtok = tok_of(Lq, a.dshift, a.ldshift);
    bf16x8 qr[NS];
    { const bf16_t* qrow = a.Q + (size_t)Lq * a.qp + 8 * hi;
#pragma unroll
      for (int s = 0; s < NS; ++s) qr[s] = *(const bf16x8*)(qrow + 16 * s); }
    {
        const int pos = qtok & (S - 1);
        float x[NS][8];
#pragma unroll
        for (int s = 0; s < NS; ++s)
#pragma unroll
            for (int j = 0; j < 8; ++j) x[s][j] = bf1((bf16_t)qr[s][j]);
        if (QMODE == 2) {
            float ss = 0.f;
#pragma unroll
            for (int s = 0; s < 4; ++s)
#pragma unroll
                for (int j = 0; j < 8; ++j) ss += x[s][j] * x[s][j];
            ss += __shfl_xor(ss, 32);
            const float rs = 1.0f / sqrtf(ss * (1.0f / 64.0f) + EPS);
#pragma unroll
            for (int s = 0; s < 4; ++s)
#pragma unroll
                for (int j = 0; j < 8; ++j) x[s][j] *= rs * a.gq[16 * s + 8 * hi + j];
            const f32x2* rr = a.rope + (pos >> 6) * 16 + 8 * hi; const f32x2* rc = a.rope + (pos & 63) * 16 + 8 * hi;
#pragma unroll
            for (int j = 0; j < 8; ++j) { const f32x2 c0 = rr[j], c1 = rc[j];
                const float a0 = x[0][j], a1 = x[1][j], b0 = x[2][j], b1 = x[3][j];
                x[0][j] = a0 * c0.x - a1 * c0.y; x[1][j] = a0 * c0.y + a1 * c0.x; x[2][j] = b0 * c1.x - b1 * c1.y; x[3][j] = b0 * c1.y + b1 * c1.x; }
        } else if (QMODE == 1) {
            const f32x2* rp = a.rope + pos * 16 + 8 * hi;
#pragma unroll
            for (int j = 0; j < 8; ++j) { const f32x2 c0 = rp[j]; const float a0 = x[NS - 2][j], a1 = x[NS - 1][j]; x[NS - 2][j] = a0 * c0.x - a1 * c0.y; x[NS - 1][j] = a0 * c0.y + a1 * c0.x; }
        }
#pragma unroll
        for (int s = 0; s < NS; ++s) { u32x4 w;
            w.x = pk2(x[s][0] * a.c2, x[s][1] * a.c2); w.y = pk2(x[s][2] * a.c2, x[s][3] * a.c2); w.z = pk2(x[s][4] * a.c2, x[s][5] * a.c2); w.w = pk2(x[s][6] * a.c2, x[s][7] * a.c2);
            qr[s] = __builtin_bit_cast(bf16x8, w); }
    }
    float m_run = SINK ? a.sink2 : -1e30f, l_run = (SINK && hi == 0) ? 1.0f : 0.0f;
    f32x16 o0, o1;
#pragma unroll
    for (int r = 0; r < 16; ++r) { o0[r] = 0.f; o1[r] = 0.f; }
    const int koff = hi * 1024 + r32 * 16;
    const int voff = KB + ((lane >> 4) & 1) * 32 + (lane & 3) * 8 + (4 * hi + ((lane & 15) >> 2)) * 64;
#define ATT_ACTIVE(t) (!BANDED || (((t) * 64 < whi) && ((t) * 64 + 64 > wlo)))
#define ATT_QK(P0, P1, slot) do { const LAS unsigned char* ks_ = lds + (slot) * SLOT + koff; bf16x8 kf0[NS], kf1[NS]; \
        _Pragma("unroll") for (int s = 0; s < NS; ++s) { kf0[s] = *(const LAS bf16x8*)(ks_ + s * 2048); kf1[s] = *(const LAS bf16x8*)(ks_ + s * 2048 + 512); } \
        _Pragma("unroll") for (int r = 0; r < 16; ++r) { P0[r] = 0.f; P1[r] = 0.f; } \
        _Pragma("unroll") for (int s = 0; s < NS; ++s) { P0 = __builtin_amdgcn_mfma_f32_32x32x16_bf16(kf0[s], qr[s], P0, 0, 0, 0); P1 = __builtin_amdgcn_mfma_f32_32x32x16_bf16(kf1[s], qr[s], P1, 0, 0, 0); } } while (0)
    f32x16 p0, p1, n0, n1;
    int ta = t0, tb = t1;
    if (BANDED) {
        asm volatile("s_waitcnt vmcnt(0)" ::: "memory");
        __builtin_amdgcn_s_barrier(); asm volatile("" ::: "memory");
        ta = max(t0, wlo >> 6); tb = min(t1, (whi + 63) >> 6);
        ATT_QK(p0, p1, ta - t0);
    } else {
        { const int ahead = min(t1 - 1 - t0, 2); ATT_WAIT(ahead); }
        __builtin_amdgcn_s_barrier(); asm volatile("" ::: "memory");
        if (t0 + 3 < t1) ATT_DMA(t0 + 3, 3);
        ATT_QK(p0, p1, 0);
    }
#define ATT_SOFTMAX_PV(t, sl) do { \
            const LAS unsigned char* ks = lds + (sl) * SLOT; \
            float mx; \
            if (BANDED) { \
                const float d0f = (float)((t) * 64 + 4 * hi - Lq); \
                mx = -1e30f; \
                if ((t) * 64 >= wfull_lo && (t) * 64 + 64 <= wfull_hi) {        \
                    _Pragma("unroll") for (int r = 0; r < 16; ++r) { const float df = d0f + (float)((r & 3) + 8 * (r >> 2)); \
                        p0[r] = __builtin_fmaf(-a.slope2, __builtin_fabsf(df), p0[r]); p1[r] = __builtin_fmaf(-a.slope2, __builtin_fabsf(df + 32.f), p1[r]); \
                        mx = __builtin_fmaxf(__builtin_fmaxf(mx, p0[r]), p1[r]); } \
                } else { \
                    _Pragma("unroll") for (int r = 0; r < 16; ++r) { const float df = d0f + (float)((r & 3) + 8 * (r >> 2)), dg = df + 32.f; \
                        const float v0 = __builtin_fmaf(-a.slope2, __builtin_fabsf(df), p0[r]), v1 = __builtin_fmaf(-a.slope2, __builtin_fabsf(dg), p1[r]); \
                        p0[r] = (df >= flo && df <= fhi) ? v0 : -1e30f; p1[r] = (dg >= flo && dg <= fhi) ? v1 : -1e30f; \
                        mx = __builtin_fmaxf(__builtin_fmaxf(mx, p0[r]), p1[r]); } \
                } \
            } else { \
                float ma = __builtin_fmaxf(__builtin_fmaxf(p0[0], p0[1]), p1[0]), mb = __builtin_fmaxf(__builtin_fmaxf(p0[2], p0[3]), p1[1]); \
                ma = __builtin_fmaxf(__builtin_fmaxf(ma, p1[2]), p1[3]); \
                _Pragma("unroll") for (int r = 4; r < 16; r += 4) { ma = __builtin_fmaxf(__builtin_fmaxf(ma, p0[r]), p0[r + 1]); mb = __builtin_fmaxf(__builtin_fmaxf(mb, p0[r + 2]), p0[r + 3]); \
                    ma = __builtin_fmaxf(__builtin_fmaxf(ma, p1[r]), p1[r + 1]); mb = __builtin_fmaxf(__builtin_fmaxf(mb, p1[r + 2]), p1[r + 3]); } \
                mx = __builtin_fmaxf(ma, mb); \
            } \
            mx = __builtin_fmaxf(mx, __shfl_xor(mx, 32)); \
            { const float mn = __builtin_fmaxf(m_run, mx); const float alpha = __builtin_amdgcn_exp2f(m_run - mn); m_run = mn; l_run *= alpha; \
              _Pragma("unroll") for (int r = 0; r < 16; ++r) { o0[r] *= alpha; o1[r] *= alpha; } } \
            float ls0 = 0.f, ls1 = 0.f; \
            _Pragma("unroll") for (int r = 0; r < 16; ++r) { p0[r] = __builtin_amdgcn_exp2f(p0[r] - m_run); p1[r] = __builtin_amdgcn_exp2f(p1[r] - m_run); ls0 += p0[r]; ls1 += p1[r]; } \
            l_run += ls0 + ls1; \
            bf16x8 pf[4]; \
            { u32x4 w; \
              w.x = pk2(p0[0], p0[1]); w.y = pk2(p0[2], p0[3]); w.z = pk2(p0[4], p0[5]); w.w = pk2(p0[6], p0[7]); pf[0] = __builtin_bit_cast(bf16x8, w); \
              w.x = pk2(p0[8], p0[9]); w.y = pk2(p0[10], p0[11]); w.z = pk2(p0[12], p0[13]); w.w = pk2(p0[14], p0[15]); pf[1] = __builtin_bit_cast(bf16x8, w); \
              w.x = pk2(p1[0], p1[1]); w.y = pk2(p1[2], p1[3]); w.z = pk2(p1[4], p1[5]); w.w = pk2(p1[6], p1[7]); pf[2] = __builtin_bit_cast(bf16x8, w); \
              w.x = pk2(p1[8], p1[9]); w.y = pk2(p1[10], p1[11]); w.z = pk2(p1[12], p1[13]); w.w = pk2(p1[14], p1[15]); pf[3] = __builtin_bit_cast(bf16x8, w); } \
            const LAS unsigned char* vs = ks + voff; \
            _Pragma("unroll") for (int kk = 0; kk < 4; ++kk) { \
                const s16x4 a0 = vtr(vs + kk * 1024), a1 = vtr(vs + kk * 1024 + 512), b0 = vtr(vs + 4096 + kk * 1024), b1 = vtr(vs + 4096 + kk * 1024 + 512); \
                const bf16x8 v0 = (bf16x8){a0[0], a0[1], a0[2], a0[3], a1[0], a1[1], a1[2], a1[3]}, v1 = (bf16x8){b0[0], b0[1], b0[2], b0[3], b1[0], b1[1], b1[2], b1[3]}; \
                o0 = __builtin_amdgcn_mfma_f32_32x32x16_bf16(v0, pf[kk], o0, 0, 0, 0); \
                o1 = __builtin_amdgcn_mfma_f32_32x32x16_bf16(v1, pf[kk], o1, 0, 0, 0); } \
        } while (0)
    if (BANDED) {
        for (int t = ta; t < tb; ++t) {
            if (t + 1 < tb) ATT_QK(n0, n1, t + 1 - t0);
            ATT_SOFTMAX_PV(t, t - t0);
            p0 = n0; p1 = n1;
        }
    } else {
        for (int t = t0; t < t1 - 1; ++t) {
            const int sl = (t - t0) & 3;
            { const int ahead = min(t1 - 2 - t, 1); ATT_WAIT(ahead); }
            __builtin_amdgcn_s_barrier(); asm volatile("" ::: "memory");
            if (t >= t0 + 1 && t + 3 < t1) ATT_DMA(t + 3, (sl + 3) & 3);
            ATT_QK(n0, n1, (sl + 1) & 3);
            ATT_SOFTMAX_PV(t, sl);
#pragma unroll
            for (int i = 0; i < (ATT_SGB ? 2 * NS : 0); ++i) { __builtin_amdgcn_sched_group_barrier(0x008, 1, 0); __builtin_amdgcn_sched_group_barrier(0x002, (DQ == 96 ? 9 : 13), 0); }
            p0 = n0; p1 = n1;
        }
        ATT_SOFTMAX_PV(t1 - 1, (t1 - 1 - t0) & 3);
    }
#undef ATT_SOFTMAX_PV
    asm volatile("s_waitcnt lgkmcnt(0)" ::: "memory");
    __builtin_amdgcn_s_barrier();
#undef ATT_ACTIVE
#undef ATT_QK
#undef ATT_DMA
#undef ATT_WAIT
    const float lt = l_run + __shfl_xor(l_run, 32);
    const float inv = 1.0f / lt;
    bf16_t* orow = a.O + (size_t)qtok * a.op + 4 * hi;
#pragma unroll
    for (int g4 = 0; g4 < 4; ++g4) {
        u32x2 w0, w1; w0.x = pk2(o0[4 * g4] * inv, o0[4 * g4 + 1] * inv); w0.y = pk2(o0[4 * g4 + 2] * inv, o0[4 * g4 + 3] * inv);
        w1.x = pk2(o1[4 * g4] * inv, o1[4 * g4 + 1] * inv); w1.y = pk2(o1[4 * g4 + 2] * inv, o1[4 * g4 + 3] * inv);
        *(u32x2*)(orow + 8 * g4) = w0; *(u32x2*)(orow + 32 + 8 * g4) = w1;
    }
    if (LSE_OUT) { if (hi == 0) a.lse[(size_t)qtok * 8] = (m_run + __builtin_amdgcn_logf(lt)) * LN2; }
}

template <int DQ, int QMODE>
__device__ __forceinline__ void load_q(const AttnArgs& a, const bf16_t* Qb, int qtok, int hi, bf16x8 (&qr)[DQ / 16]) {
    constexpr int NS = DQ / 16;
    { const bf16_t* qrow = Qb + (size_t)qtok * a.qp + 8 * hi;
#pragma unroll
      for (int s = 0; s < NS; ++s) qr[s] = *(const bf16x8*)(qrow + 16 * s); }
    const int pos = qtok & (S - 1);
    float x[NS][8];
#pragma unroll
    for (int s = 0; s < NS; ++s)
#pragma unroll
        for (int j = 0; j < 8; ++j) x[s][j] = bf1((bf16_t)qr[s][j]);
    if (QMODE == 2) {
        float ss = 0.f;
#pragma unroll
        for (int s = 0; s < 4; ++s)
#pragma unroll
            for (int j = 0; j < 8; ++j) ss += x[s][j] * x[s][j];
        ss += __shfl_xor(ss, 32);
        const float rs = 1.0f / sqrtf(ss * (1.0f / 64.0f) + EPS);
#pragma unroll
        for (int s = 0; s < 4; ++s)
#pragma unroll
            for (int j = 0; j < 8; ++j) x[s][j] *= rs * a.gq[16 * s + 8 * hi + j];
        const f32x2* rr = a.rope + (pos >> 6) * 16 + 8 * hi; const f32x2* rc = a.rope + (pos & 63) * 16 + 8 * hi;
#pragma unroll
        for (int j = 0; j < 8; ++j) { const f32x2 c0 = rr[j], c1 = rc[j];
            const float a0 = x[0][j], a1 = x[1][j], b0 = x[2][j], b1 = x[3][j];
            x[0][j] = a0 * c0.x - a1 * c0.y; x[1][j] = a0 * c0.y + a1 * c0.x; x[2][j] = b0 * c1.x - b1 * c1.y; x[3][j] = b0 * c1.y + b1 * c1.x; }
    } else if (QMODE == 1) {
        const f32x2* rp = a.rope + pos * 16 + 8 * hi;
#pragma unroll
        for (int j = 0; j < 8; ++j) { const f32x2 c0 = rp[j]; const float a0 = x[NS - 2][j], a1 = x[NS - 1][j]; x[NS - 2][j] = a0 * c0.x - a1 * c0.y; x[NS - 1][j] = a0 * c0.y + a1 * c0.x; }
    }
#pragma unroll
    for (int s = 0; s < NS; ++s) { u32x4 w;
        w.x = pk2(x[s][0] * a.c2, x[s][1] * a.c2); w.y = pk2(x[s][2] * a.c2, x[s][3] * a.c2); w.z = pk2(x[s][4] * a.c2, x[s][5] * a.c2); w.w = pk2(x[s][6] * a.c2, x[s][7] * a.c2);
        qr[s] = __builtin_bit_cast(bf16x8, w); }
}
template <int DQ, int QMODE>
__device__ __forceinline__ void attn_unit2(const AttnArgs& a, int dL, int dQ, int dO, LAS unsigned char* lds) {
    constexpr int NS = DQ / 16, KB = DQ * 128, SLOT = KB + 8192;
    int tid_ = threadIdx.x; asm volatile("" : "+v"(tid_));
    const int tid = tid_, lane = tid & 63, r32 = lane & 31, hi = lane >> 5; const int wid = __builtin_amdgcn_readfirstlane(tid >> 6);
    const int t0 = (a.L0 & ~2047) >> 6, t1 = t0 + 32;
    const int vkey = 16 * (wid & 3) + (lane >> 2), vcol = 32 * (wid >> 2) + 8 * (lane & 3);
    const bool rope_wave = (DQ == 96) && (wid < 4);
    const unsigned lds0 = (unsigned)(size_t)lds;
#define A2_DMA(t, slot) do { const int tk_ = (t) * 64 + lane, tv_ = (t) * 64 + vkey; const unsigned s_ = lds0 + (unsigned)((slot) * SLOT); \
        glds16(a.K + (size_t)tk_ * a.kp + 8 * wid, (unsigned)__builtin_amdgcn_readfirstlane(s_ + wid * 1024)); \
        if (rope_wave) glds16(a.K2 + (size_t)tk_ * 32 + 8 * wid, (unsigned)__builtin_amdgcn_readfirstlane(s_ + (8 + wid) * 1024)); \
        glds16(a.V + (size_t)tv_ * a.vp + vcol, (unsigned)__builtin_amdgcn_readfirstlane(s_ + KB + wid * 1024)); } while (0)
#define A2_WAIT(nahead) do { if (rope_wave) { if ((nahead) >= 2) asm volatile("s_waitcnt vmcnt(6)" ::: "memory"); else if ((nahead) == 1) asm volatile("s_waitcnt vmcnt(3)" ::: "memory"); else asm volatile("s_waitcnt vmcnt(0)" ::: "memory"); } \
        else { if ((nahead) >= 2) asm volatile("s_waitcnt vmcnt(4)" ::: "memory"); else if ((nahead) == 1) asm volatile("s_waitcnt vmcnt(2)" ::: "memory"); else asm volatile("s_waitcnt vmcnt(0)" ::: "memory"); } } while (0)
    A2_DMA(t0, 0); A2_DMA(t0 + 1, 1); A2_DMA(t0 + 2, 2);
    const int Lq = a.L0 + 32 * wid + r32;
    const int qtokA = Lq, qtokB = Lq + dL;
    bf16x8 qa[NS], qb[NS];
    load_q<DQ, QMODE>(a, a.Q, qtokA, hi, qa);
    load_q<DQ, QMODE>(a, a.Q + dQ, qtokB, hi, qb);
    float mA = -1e30f, lA = 0.f, mB = -1e30f, lB = 0.f;
    f32x16 oA0, oA1, oB0, oB1;
#pragma unroll
    for (int r = 0; r < 16; ++r) { oA0[r] = 0.f; oA1[r] = 0.f; oB0[r] = 0.f; oB1[r] = 0.f; }
    const int koff = hi * 1024 + r32 * 16;
    const int voff = KB + ((lane >> 4) & 1) * 32 + (lane & 3) * 8 + (4 * hi + ((lane & 15) >> 2)) * 64;
#define A2_ROWMAX(P0, P1, MX) do { \
        float ma = __builtin_fmaxf(__builtin_fmaxf(P0[0], P0[1]), P1[0]), mb = __builtin_fmaxf(__builtin_fmaxf(P0[2], P0[3]), P1[1]); \
        ma = __builtin_fmaxf(__builtin_fmaxf(ma, P1[2]), P1[3]); \
        _Pragma("unroll") for (int r = 4; r < 16; r += 4) { ma = __builtin_fmaxf(__builtin_fmaxf(ma, P0[r]), P0[r + 1]); mb = __builtin_fmaxf(__builtin_fmaxf(mb, P0[r + 2]), P0[r + 3]); \
            ma = __builtin_fmaxf(__builtin_fmaxf(ma, P1[r]), P1[r + 1]); mb = __builtin_fmaxf(__builtin_fmaxf(mb, P1[r + 2]), P1[r + 3]); } \
        MX = __builtin_fmaxf(ma, mb); } while (0)
#define A2_EXP_PACK(P0, P1, LR, PF) do { \
        float ls0 = 0.f, ls1 = 0.f; \
        _Pragma("unroll") for (int r = 0; r < 16; ++r) { P0[r] = __builtin_amdgcn_exp2f(P0[r]); P1[r] = __builtin_amdgcn_exp2f(P1[r]); ls0 += P0[r]; ls1 += P1[r]; } \
        LR += ls0 + ls1; \
        { u32x4 w; \
          w.x = pk2(P0[0], P0[1]); w.y = pk2(P0[2], P0[3]); w.z = pk2(P0[4], P0[5]); w.w = pk2(P0[6], P0[7]); PF[0] = __builtin_bit_cast(bf16x8, w); \
          w.x = pk2(P0[8], P0[9]); w.y = pk2(P0[10], P0[11]); w.z = pk2(P0[12], P0[13]); w.w = pk2(P0[14], P0[15]); PF[1] = __builtin_bit_cast(bf16x8, w); \
          w.x = pk2(P1[0], P1[1]); w.y = pk2(P1[2], P1[3]); w.z = pk2(P1[4], P1[5]); w.w = pk2(P1[6], P1[7]); PF[2] = __builtin_bit_cast(bf16x8, w); \
          w.x = pk2(P1[8], P1[9]); w.y = pk2(P1[10], P1[11]); w.z = pk2(P1[12], P1[13]); w.w = pk2(P1[14], P1[15]); PF[3] = __builtin_bit_cast(bf16x8, w); } } while (0)
#define A2_TILE(t, FIRST) do { \
        const int sl = ((t) - t0) & 3; \
        { const int ahead = min(t1 - 1 - (t), 2); A2_WAIT(ahead); } \
        __builtin_amdgcn_s_barrier(); asm volatile("" ::: "memory"); \
        if ((t) + 3 < t1) A2_DMA((t) + 3, (sl + 3) & 3); \
        const LAS unsigned char* ks = lds + sl * SLOT; \
        f32x16 a0, a1, b0, b1; \
        { const float ia = FIRST ? 0.f : -mA, ib = FIRST ? 0.f : -mB; \
          _Pragma("unroll") for (int r = 0; r < 16; ++r) { a0[r] = ia; a1[r] = ia; b0[r] = ib; b1[r] = ib; } } \
        _Pragma("unroll") for (int s = 0; s < NS; ++s) { const bf16x8 k0 = *(const LAS bf16x8*)(ks + koff + s * 2048), k1 = *(const LAS bf16x8*)(ks + koff + s * 2048 + 512); \
            a0 = __builtin_amdgcn_mfma_f32_32x32x16_bf16(k0, qa[s], a0, 0, 0, 0); a1 = __builtin_amdgcn_mfma_f32_32x32x16_bf16(k1, qa[s], a1, 0, 0, 0); \
            b0 = __builtin_amdgcn_mfma_f32_32x32x16_bf16(k0, qb[s], b0, 0, 0, 0); b1 = __builtin_amdgcn_mfma_f32_32x32x16_bf16(k1, qb[s], b1, 0, 0, 0); \
            if (DQ == 96) asm volatile("" ::: "memory"); } \
        bf16x8 pfA[4], pfB[4]; float mxA, mxB; \
        A2_ROWMAX(a0, a1, mxA); A2_ROWMAX(b0, b1, mxB); \
        if (FIRST) { mxA = __builtin_fmaxf(mxA, __shfl_xor(mxA, 32)); mxB = __builtin_fmaxf(mxB, __shfl_xor(mxB, 32)); mA = mxA; mB = mxB; \
            _Pragma("unroll") for (int r = 0; r < 16; ++r) { a0[r] -= mxA; a1[r] -= mxA; b0[r] -= mxB; b1[r] -= mxB; } } \
        A2_EXP_PACK(a0, a1, lA, pfA); \
        __builtin_amdgcn_sched_barrier(0); \
        A2_EXP_PACK(b0, b1, lB, pfB); \
        const LAS unsigned char* vs = ks + voff; \
        _Pragma("unroll") for (int kk = 0; kk < 4; ++kk) { \
            const s16x4 x0 = vtr(vs + kk * 1024), x1 = vtr(vs + kk * 1024 + 512), y0 = vtr(vs + 4096 + kk * 1024), y1 = vtr(vs + 4096 + kk * 1024 + 512); \
            const bf16x8 v0 = (bf16x8){x0[0], x0[1], x0[2], x0[3], x1[0], x1[1], x1[2], x1[3]}, v1 = (bf16x8){y0[0], y0[1], y0[2], y0[3], y1[0], y1[1], y1[2], y1[3]}; \
            oA0 = __builtin_amdgcn_mfma_f32_32x32x16_bf16(v0, pfA[kk], oA0, 0, 0, 0); oA1 = __builtin_amdgcn_mfma_f32_32x32x16_bf16(v1, pfA[kk], oA1, 0, 0, 0); \
            oB0 = __builtin_amdgcn_mfma_f32_32x32x16_bf16(v0, pfB[kk], oB0, 0, 0, 0); oB1 = __builtin_amdgcn_mfma_f32_32x32x16_bf16(v1, pfB[kk], oB1, 0, 0, 0); } \
        if (!(FIRST)) { \
            _Pragma("unroll") for (int i = 0; i < (A2_SGB ? 4 * NS + 16 : 0); ++i) { __builtin_amdgcn_sched_group_barrier(0x008, 1, 0); __builtin_amdgcn_sched_group_barrier(0x002, 8, 0); } \
            mxA = __builtin_fmaxf(mxA, __shfl_xor(mxA, 32)); mxB = __builtin_fmaxf(mxB, __shfl_xor(mxB, 32)); \
            if (__any(__builtin_fmaxf(mxA, mxB) > 8.0f)) { \
                const float dA = __builtin_fmaxf(mxA, 0.f), dB = __builtin_fmaxf(mxB, 0.f), fA = __builtin_amdgcn_exp2f(-dA), fB = __builtin_amdgcn_exp2f(-dB); mA += dA; mB += dB; lA *= fA; lB *= fB; \
                _Pragma("unroll") for (int r = 0; r < 16; ++r) { oA0[r] *= fA; oA1[r] *= fA; oB0[r] *= fB; oB1[r] *= fB; } } } \
    } while (0)
    A2_TILE(t0, true);
    for (int t = t0 + 1; t < t1; ++t) A2_TILE(t, false);
#undef A2_TILE
    asm volatile("s_waitcnt lgkmcnt(0)" ::: "memory");
    __builtin_amdgcn_s_barrier();
#undef A2_DMA
#undef A2_WAIT
#undef A2_ROWMAX
#undef A2_EXP_PACK
#define A2_STORE(O0, O1, LR, OB, QT) do { const float lt = LR + __shfl_xor(LR, 32); const float inv = 1.0f / lt; bf16_t* orow = (OB) + (size_t)(QT) * a.op + 4 * hi; \
        _Pragma("unroll") for (int g4 = 0; g4 < 4; ++g4) { u32x2 w0, w1; w0.x = pk2(O0[4 * g4] * inv, O0[4 * g4 + 1] * inv); w0.y = pk2(O0[4 * g4 + 2] * inv, O0[4 * g4 + 3] * inv); \
            w1.x = pk2(O1[4 * g4] * inv, O1[4 * g4 + 1] * inv); w1.y = pk2(O1[4 * g4 + 2] * inv, O1[4 * g4 + 3] * inv); \
            *(u32x2*)(orow + 8 * g4) = w0; *(u32x2*)(orow + 32 + 8 * g4) = w1; } } while (0)
    { int t2_ = threadIdx.x; asm volatile("" : "+v"(t2_));
      const int qA_ = a.L0 + 32 * wid + (t2_ & 31), qB_ = qA_ + dL;
      A2_STORE(oA0, oA1, lA, a.O, qA_);
      A2_STORE(oB0, oB1, lB, a.O + dO, qB_); }
#undef A2_STORE
}

__device__ __forceinline__ void combine_a(const Frame& F) {
    const bf16_t* OA = (const bf16_t*)(F.ws + WS_OA3); const float* LSE = (const float*)(F.ws + WS_LSE); bf16_t* OC = (bf16_t*)(F.ws + WS_OCAT);
    const int gw = F.bid * NWAVES + F.wave, NGW = F.G * NWAVES, lane = F.lane, h = lane >> 3;
    for (int t = gw; t < T; t += NGW) {
        const float l0 = LSE[(size_t)t * 8 + h], l1 = LSE[(size_t)(T + t) * 8 + h], l2 = LSE[(size_t)(2 * T + t) * 8 + h];
        const float mx = fmaxf(l0, fmaxf(l1, l2)); float w0 = __expf(l0 - mx), w1 = __expf(l1 - mx), w2 = __expf(l2 - mx); const float inv = 1.0f / (w0 + w1 + w2); w0 *= inv; w1 *= inv; w2 *= inv;
        const u32x4 a = *(const u32x4*)(OA + (size_t)t * 512 + 8 * lane), b = *(const u32x4*)(OA + (size_t)(T + t) * 512 + 8 * lane), c = *(const u32x4*)(OA + (size_t)(2 * T + t) * 512 + 8 * lane);
        u32x4 o;
        o.x = pk2(w0 * bflo(a.x) + w1 * bflo(b.x) + w2 * bflo(c.x), w0 * bfhi(a.x) + w1 * bfhi(b.x) + w2 * bfhi(c.x));
        o.y = pk2(w0 * bflo(a.y) + w1 * bflo(b.y) + w2 * bflo(c.y), w0 * bfhi(a.y) + w1 * bfhi(b.y) + w2 * bfhi(c.y));
        o.z = pk2(w0 * bflo(a.z) + w1 * bflo(b.z) + w2 * bflo(c.z), w0 * bfhi(a.z) + w1 * bfhi(b.z) + w2 * bfhi(c.z));
        o.w = pk2(w0 * bflo(a.w) + w1 * bflo(b.w) + w2 * bflo(c.w), w0 * bfhi(a.w) + w1 * bfhi(b.w) + w2 * bfhi(c.w));
        *(u32x4*)(OC + (size_t)t * 2048 + 8 * lane) = o;
    }
}

__device__ __forceinline__ void topk_gather(const Frame& F) {
    const float* probs = (const float*)(F.ws + WS_PROBS); int* IDX = (int*)(F.ws + WS_IDX); float* GV = (float*)(F.ws + WS_GV); short* SEL = (short*)(F.ws + WS_SEL);
    const unsigned char* XN = F.ws + WS_XN8; unsigned char* XE = F.ws + WS_XE;
    LAS unsigned* cnt = (LAS unsigned*)F.lds;
    LAS int* lidx = (LAS int*)(F.lds + 256);
    const int tid = F.tid, lane = F.lane, wave = F.wave;
    for (int wu = F.bid; wu < 2 * NB * NE; wu += F.G) {
        const int u = wu >> 1, half = wu & 1, b = u >> 4, e = u & 15;
        unsigned key[4];
#pragma unroll
        for (int j = 0; j < 4; ++j) key[j] = __builtin_bit_cast(unsigned, probs[(size_t)(b * S + 4 * tid + j) * NE + e]);
        unsigned thr = 0u; int needk = CAP;
        LAS unsigned* hist = (LAS unsigned*)(F.lds + 2048);
#pragma unroll 1
        for (int pass = 0; pass < 4; ++pass) {
            const int shift = 24 - 8 * pass;
            if (tid < 256) hist[tid] = 0u;
            __syncthreads();
#pragma unroll
            for (int j = 0; j < 4; ++j) { const bool match = (pass == 0) || ((key[j] >> (shift + 8)) == (thr >> (shift + 8))); if (match) __hip_atomic_fetch_add(hist + ((key[j] >> shift) & 255u), 1u, __ATOMIC_RELAXED, __HIP_MEMORY_SCOPE_WORKGROUP); }
            __syncthreads();
            if (wave == 0) {
                const unsigned h0 = hist[4 * lane], h1 = hist[4 * lane + 1], h2 = hist[4 * lane + 2], h3 = hist[4 * lane + 3];
                const unsigned own = h0 + h1 + h2 + h3; unsigned suf = own;
#pragma unroll
                for (int o = 1; o < 64; o <<= 1) { const unsigned t2 = __shfl_down(suf, o); if (lane + o < 64) suf += t2; }
                const unsigned above = suf - own;
                if (above < (unsigned)needk && suf >= (unsigned)needk) {
                    unsigned acc = above; int bsel; unsigned rem;
                    if (acc + h3 >= (unsigned)needk) { bsel = 4 * lane + 3; rem = (unsigned)needk - acc; }
                    else { acc += h3; if (acc + h2 >= (unsigned)needk) { bsel = 4 * lane + 2; rem = (unsigned)needk - acc; }
                    else { acc += h2; if (acc + h1 >= (unsigned)needk) { bsel = 4 * lane + 1; rem = (unsigned)needk - acc; }
                    else { acc += h1; bsel = 4 * lane; rem = (unsigned)needk - acc; } } }
                    hist[256] = (unsigned)bsel; hist[257] = rem;
                }
            }
            __syncthreads();
            thr |= hist[256] << shift; needk = (int)hist[257];
            __syncthreads();
        }
        int ngt_l = 0, neq_l = 0;
#pragma unroll
        for (int j = 0; j < 4; ++j) { ngt_l += key[j] > thr; neq_l += key[j] == thr; }
        int sg = ngt_l, se = neq_l;
#pragma unroll
        for (int o = 1; o < 64; o <<= 1) { const int a = __shfl_up(sg, o), c2 = __shfl_up(se, o); if (lane >= o) { sg += a; se += c2; } }
        if (lane == 63) { cnt[8 + wave] = (unsigned)sg; cnt[16 + wave] = (unsigned)se; }
        __syncthreads();
        int bg = 0, be = 0, totg = 0;
#pragma unroll
        for (int w = 0; w < NWAVES; ++w) { const int a = (int)cnt[8 + w], c2 = (int)cnt[16 + w]; if (w < wave) { bg += a; be += c2; } totg += a; }
        const int need = CAP - totg;
        int pg = bg + sg - ngt_l, pe = be + se - neq_l;
#pragma unroll
        for (int j = 0; j < 4; ++j) {
            const int tkn = 4 * tid + j; int slot = -1;
            if (key[j] > thr) { slot = pg + min(pe, need); ++pg; }
            else if (key[j] == thr) { if (pe < need) slot = pg + pe; ++pe; }
            if (slot >= 0) { lidx[slot] = tkn; if (half == 0) { IDX[u * CAP + slot] = tkn; GV[u * CAP + slot] = __builtin_bit_cast(float, key[j]); } }
            if (half == 0) SEL[(size_t)(b * S + tkn) * NE + e] = (short)slot;
        }
        __syncthreads();
        for (int r0 = 0; r0 < 16; r0 += 8) { u32x4 buf[8][2];
#pragma unroll
            for (int r = 0; r < 8; ++r) { const int slot = half * 128 + wave * 16 + r0 + r; const int tkn = lidx[slot]; const u32x4* src = (const u32x4*)(XN + (size_t)(b * S + tkn) * DM);
                buf[r][0] = src[lane]; buf[r][1] = src[lane + 64]; }
#pragma unroll
            for (int r = 0; r < 8; ++r) { const int slot = half * 128 + wave * 16 + r0 + r; u32x4* dst = (u32x4*)(XE + (size_t)(u * CAP + slot) * DM);
                dst[lane] = buf[r][0]; dst[lane + 64] = buf[r][1]; } }
        __syncthreads();
    }
}

__global__ void __launch_bounds__(NTHR, 2) fwd_kernel(Args args) {
    extern __shared__ __attribute__((aligned(16))) unsigned char lds_raw[];
    Frame F;
    kargp_t kp = (kargp_t)__builtin_amdgcn_kernarg_segment_ptr(); asm volatile("" : "+s"(kp));
    F.kp = kp; F.lds = (LAS unsigned char*)lds_raw; F.ws = KARG_WS(kp); F.ctl = (gu32*)(F.ws + WS_CTL);
    F.tid = threadIdx.x; F.lane = F.tid & 63; F.wave = __builtin_amdgcn_readfirstlane(F.tid >> 6); F.bid = blockIdx.x; F.G = gridDim.x;
    volatile LAS unsigned* MISC = (volatile LAS unsigned*)(F.lds + MISC_OFF);
    if (F.tid < 128) MISC[F.tid] = 0u;
    __syncthreads();
    XcdBarrier bar; bar.bar = (unsigned*)(F.ctl + CW_BAR); bar.x = 0; bar.st = nullptr;
    if (!MK_PER_PHASE) bar = xcd_barrier_post((unsigned*)(F.ctl + CW_BAR), MISC + 8);
    const int lo = KARG_LO(kp), hi = KARG_HI(kp);
#ifndef PHMASK
#define PHMASK 0xFFFFFFFFu
#endif
#define IN(k) ((((PHMASK) >> ((k) % NPH + ((k) >= PH_FINAL ? NPH : 0))) & 1u) && lo <= (k) && (k) < hi)
#if TSPROBE
    gu32* TSW = F.ctl + 262144;
#define TS_NOW() ((unsigned)__builtin_amdgcn_s_memrealtime())
#define TS_BEGIN(k) do { if (threadIdx.x == 0) { const unsigned tb_ = TS_NOW(); MISC[16] = tb_; __hip_atomic_fetch_max(TSW + 32 + (k), ~tb_, RLX_AGENT); } } while (0)
#define TS_END(k) do { if (threadIdx.x == 0) { const unsigned te_ = TS_NOW(); __hip_atomic_fetch_max(TSW + (k), te_, RLX_AGENT); __hip_atomic_fetch_add(TSW + 64 + (k), te_ - MISC[16], RLX_AGENT); } } while (0)
    TS_BEGIN(0);
#else
#define TS_BEGIN(k) do { } while (0)
#define TS_END(k) do { } while (0)
#endif
#define SEAM(k) do { if (IN(k) && IN((k) + 1)) { TS_END(k); { XcdBarrier b_ = bar; asm volatile("" : "+s"(b_.bar)); xcd_barrier(b_); } TS_BEGIN((k) + 1); } } while (0)
    unsigned char* ws = F.ws;
#define XN ((bf16_t*)(ws + WS_XN))
#define PA ((bf16_t*)(ws + WS_PA))
#define PC ((bf16_t*)(ws + WS_PC))
#define PD ((bf16_t*)(ws + WS_PD))
#define PB ((bf16_t*)(ws + WS_PB))
#define GT ((bf16_t*)(ws + WS_GATE))
#define QB ((bf16_t*)(ws + WS_QB))
#define KVB ((bf16_t*)(ws + WS_KVB))
#define KC ((bf16_t*)(ws + WS_KC))
#define KPE ((bf16_t*)(ws + WS_KPE))
#define OA3 ((bf16_t*)(ws + WS_OA3))
#define LSE ((float*)(ws + WS_LSE))
#define OCAT ((bf16_t*)(ws + WS_OCAT))
#define ROPE ((const f32x2*)(ws + WS_ROPE))
#define out KARG_OUT(kp)
#define PHASE_FRAME() do { int t_ = threadIdx.x; asm volatile("" : "+v"(t_)); F.tid = t_; F.lane = t_ & 63; F.wave = __builtin_amdgcn_readfirstlane(t_ >> 6); } while (0)

    for (int l = 0; l < DEPTH; ++l) {
        const int p0 = l * NPH;
#define REPS(k) ((((PROBE_REP) >> (k)) & 1u) ? 2 : 1)
        { asm volatile("" : "+s"(kp)); F.kp = kp; size_t z_ = 0; asm volatile("" : "+s"(z_)); unsigned char* w_ = KARG_WS(kp) + z_; ws = w_; F.ws = w_; F.ctl = (gu32*)(w_ + WS_CTL);
        }
        float* sqp = (float*)(ws + WS_SQP);
        if (IN(p0 + 0)) { PHASE_FRAME();
            for (int rep = 0; rep < REPS(0); ++rep) conv_layer(F, l);
            if (l == 0) norm_rows<0>(F, KARG_IN(kp, I_X), nullptr, KARG_IN(kp, I_GATTN), XN);
            else norm_rows<1>(F, out, out, KARG_IN(kp, I_GATTN) + l * DM, XN);
        }
        SEAM(p0 + 0);
        if (IN(p0 + 1)) for (int rep = 0; rep < REPS(1); ++rep) { PHASE_FRAME();
            pg8::Gemm g8{1024, 1024, 1024};
            if (PROJ_BF16) { pg8::Gemm g{2048, 2048, 2048};
              pg8::TileOrder So{(const char*)XN, (const char*)(ws + WS_WIN + 30 * MiB), 2048, 2048, T / 256, 28, F.G, F.bid};
              pg8::EpiProj E{ws, PB, sqp, 1.0f};
              pg8::gemm_phase(F.lds, g, So, E); }
            else { pg8::TileOrder So{(const char*)(ws + WS_XN8), (const char*)(ws + WS_W8), 1024, 1024, T / 256, 28, F.G, F.bid};
              pg8::EpiProj E{ws, PB, sqp, 1.0f / 64.0f};
              pg8::gemm_phase<pg8::EpiProj, pg8::TileOrder, true>(F.lds, g8, So, E); }
            { pg8::TileOrder So{(const char*)(ws + WS_XN8), (const char*)(ws + WS_W8 + (size_t)7168 * 2048), 1024, 1024, T / 256, 32, F.G, F.bid};
              pg8::EpiGate E{GT, KARG_IN(kp, I_BGATE) + (size_t)l * 4 * DM, 1.0f / 64.0f};
              pg8::gemm_phase<pg8::EpiGate, pg8::TileOrder, true>(F.lds, g8, So, E); }
        }
        SEAM(p0 + 1);
        if (IN(p0 + 2)) for (int rep = 0; rep < REPS(2); ++rep) { PHASE_FRAME();
            { pg8::Gemm g{1024, 512, 512};
              pg8::TileOrder So{(const char*)PB, (const char*)(ws + WS_WUQ), 1024, 512, T / 256, 3, F.G, F.bid};
              pg8::EpiMla E{QB, 96, sqp, 0, 8, 1.0f / 512.0f};
              pg8::gemm_phase(F.lds, g, So, E); }
            { pg8::Gemm g{1024, 256, 256};
              pg8::TileOrder So{(const char*)(PB + 512), (const char*)(ws + WS_WUKV), 1024, 256, T / 256, 4, F.G, (F.bid + 64) % F.G};
              pg8::EpiMla E{KVB, 128, sqp, 8, 4, 1.0f / 256.0f};
              pg8::gemm_phase(F.lds, g, So, E); }
            prep_rows(F, KARG_IN(kp, I_GCK) + l * 64);
        }
        SEAM(p0 + 2);
        if (IN(p0 + 3)) for (int rep = 0; rep < REPS(3); ++rep) { PHASE_FRAME();
            for (int rk = 0; rk < REPS(16); ++rk)
            for (int u = F.bid; u < 256; u += F.G) { const int b = u & 7, idx = u >> 3, h = idx >> 2, qb = idx & 3;
                AttnArgs a; a.Q = QB + (size_t)h * T * 96; a.qp = 96; a.K = KVB + (size_t)h * T * 128; a.kp = 128; a.K2 = KPE; a.V = KVB + (size_t)h * T * 128 + 64; a.vp = 128; a.O = OCAT + 512 + h * 64; a.op = 2048; a.lse = nullptr;
                a.L0 = b * S + qb * 512; a.dshift = 0; a.ldshift = 11; a.W = 0; a.c2 = 0.10206207261596575f * LOG2E; a.slope2 = 0.f; a.sink2 = 0.f; a.gq = nullptr; a.rope = ROPE;
                attn_unit2<96, 1>(a, 256, 0, 0, F.lds); }
            for (int rk = 0; rk < REPS(17); ++rk)
            for (int u = F.bid; u < 256; u += F.G) { const int b = u & 7, idx = u >> 3, hp = idx >> 3, qb = idx & 7, h = 2 * hp, kvh = h >> 2;
                AttnArgs a; a.Q = PC + (size_t)h * T * 64; a.qp = 64; a.K = KC + (size_t)kvh * T * 64; a.kp = 64; a.K2 = nullptr; a.V = PC + (size_t)(10 + kvh) * T * 64; a.vp = 64; a.O = OCAT + 1024 + h * 64; a.op = 2048; a.lse = nullptr;
                a.L0 = b * S + qb * 256; a.dshift = 0; a.ldshift = 11; a.W = 0; a.c2 = 0.125f * LOG2E; a.slope2 = 0.f; a.sink2 = 0.f; a.gq = KARG_IN(kp, I_GCQ) + l * 64; a.rope = ROPE;
                attn_unit2<64, 2>(a, 0, T * 64, 64, F.lds); }
            for (int rk = 0; rk < REPS(18); ++rk)
            for (int u = F.bid; u < 512; u += F.G) { const int b = u & 7, idx = u >> 3, h = idx >> 3, qb = idx & 7, kvh = h >> 2;
                AttnArgs a; a.Q = PD + (size_t)h * T * 64; a.qp = 64; a.K = PD + (size_t)(8 + kvh) * T * 64; a.kp = 64; a.K2 = nullptr; a.V = PD + (size_t)(10 + kvh) * T * 64; a.vp = 64; a.O = OCAT + 1536 + h * 64; a.op = 2048; a.lse = nullptr;
                a.L0 = b * S + qb * 256; a.dshift = 0; a.ldshift = 11; a.W = 128; a.c2 = 0.125f * LOG2E; a.slope2 = exp2f(-(float)(h + 1)) * LOG2E; a.sink2 = KARG_IN(kp, I_SINK)[l * 8 + h] * LOG2E; a.gq = nullptr; a.rope = ROPE;
                attn_unit<64, true, true, false, 0>(a, F.lds); }
            for (int rk = 0; rk < REPS(19); ++rk)
            for (int u = F.bid; u < 1536; u += F.G) { const int b = u & 7, idx = u >> 3, g = idx >> 6, h = (idx >> 3) & 7, qb = idx & 7; const int dsh = 2 * g;
                AttnArgs a; a.Q = PA + (size_t)(g * 8 + h) * T * 64; a.qp = 64; a.K = PA + (size_t)(24 + g * 8 + h) * T * 64; a.kp = 64; a.K2 = nullptr; a.V = PA + (size_t)(48 + g * 8 + h) * T * 64; a.vp = 64;
                a.O = OA3 + (size_t)g * T * 512 + h * 64; a.op = 512; a.lse = LSE + (size_t)g * T * 8 + h;
                a.L0 = b * S + qb * 256; a.dshift = dsh; a.ldshift = 11 - dsh; a.W = 64; a.c2 = 0.125f * LOG2E; a.slope2 = exp2f(-(float)(h + 1)) * (float)(1 << dsh) * LOG2E; a.sink2 = 0.f; a.gq = nullptr; a.rope = ROPE;
                attn_unit<64, true, false, true, 0>(a, F.lds); }
        }
        SEAM(p0 + 3);
        if (IN(p0 + 4)) { PHASE_FRAME(); combine_a(F); }
        SEAM(p0 + 4);
        if (IN(p0 + 5)) for (int rep = 0; rep < REPS(5); ++rep) { PHASE_FRAME();
            struct MergeOrder { const char* A; const char* B; int G, c;
                __device__ __forceinline__ bool next(int i, pg8::Unit& u) const { int pm, pn; if (!pg8::tile_order((i >> 2) * G + c, T / 256, 8, pm, pn)) return false; const int br = i & 3;
                    u.pm = pm; u.pn = pn; u.aux = br; u.A = A + (size_t)pm * 256 * 2048 * 2 + br * 1024; u.B = B + (size_t)pn * 256 * 2048 * 2 + br * 1024; return true; } };
            pg8::Gemm g{2048, 2048, 512};
            MergeOrder So{(const char*)OCAT, (const char*)(ws + WS_WBR), F.G, F.bid};
            pg8::EpiMerge E{GT, XN};
            pg8::gemm_phase(F.lds, g, So, E);
        }
        SEAM(p0 + 5);
        if (IN(p0 + 6)) { PHASE_FRAME();
            pg8::Gemm g{2048, 2048, 2048};
            pg8::TileOrder So{(const char*)XN, (const char*)(ws + WS_WOUT), 2048, 2048, T / 256, 8, F.G, F.bid};
            pg8::EpiOut E{l == 0 ? KARG_IN(kp, I_X) : nullptr, (const bf16_t*)(ws + WS_H), (bf16_t*)(ws + WS_H)};
            pg8::gemm_phase(F.lds, g, So, E);
        }
        SEAM(p0 + 6);
        if (IN(p0 + 7)) for (int rep = 0; rep < REPS(7); ++rep) { PHASE_FRAME(); norm2_router(F, (const bf16_t*)(ws + WS_H), KARG_IN(kp, I_GFFN) + l * DM, KARG_IN(kp, I_WROUTER) + (size_t)l * DM * NE, ws + WS_XN8, (float*)(ws + WS_PROBS)); }
        SEAM(p0 + 7);
        if (IN(p0 + 8)) for (int rep = 0; rep < REPS(8); ++rep) { PHASE_FRAME(); topk_gather(F); }
        SEAM(p0 + 8);
        if (IN(p0 + 9)) for (int rep = 0; rep < REPS(9); ++rep) { PHASE_FRAME();
            struct GuOrder { const char* A; const char* B; int G, c;
                __device__ __forceinline__ bool next(int i, pg8::Unit& u) const { const int L = i * G + c; if (L >= 1024) return false;
                    const int x = L & 7, pn = (L >> 3) & 7, jj = (L >> 6); const int j = jj * 8 + x;
                    const int e = j >> 3, b = j & 7, blk = b * NE + e;
                    u.pm = blk; u.pn = pn; u.aux = 0; u.A = A + (size_t)blk * 256 * 2048; u.B = B + ((size_t)e * 2048 + pn * 256) * 2048; return true; } };
            pg8::Gemm g{1024, 1024, 1024};
            GuOrder So{(const char*)(ws + WS_XE), (const char*)(ws + WS_WGU), F.G, F.bid};
            pg8::EpiGateUp E{ws + WS_HMID};
            pg8::gemm_phase<pg8::EpiGateUp, GuOrder, true>(F.lds, g, So, E);
        }
        SEAM(p0 + 9);
        if (IN(p0 + 10)) for (int rep = 0; rep < REPS(10); ++rep) { PHASE_FRAME();
            struct DnOrder { const char* A; const char* B; int G, c;
                __device__ __forceinline__ bool next(int i, pg8::Unit& u) const { const int L = i * G + c; if (L >= 1024) return false;
                    const int x = L & 7, pn = (L >> 3) & 7, jj = (L >> 6); const int j = jj * 8 + x; const int e = j >> 3, b = j & 7, blk = b * NE + e;
                    u.pm = blk; u.pn = pn; u.aux = 0; u.A = A + (size_t)blk * 256 * 1024; u.B = B + ((size_t)e * 2048 + pn * 256) * 1024; return true; } };
            pg8::Gemm g{512, 512, 512};
            DnOrder So{(const char*)(ws + WS_HMID), (const char*)(ws + WS_WD), F.G, F.bid};
            pg8::EpiDown E{(bf16_t*)(ws + WS_YE), (const float*)(ws + WS_GV)};
            pg8::gemm_phase<pg8::EpiDown, DnOrder, true>(F.lds, g, So, E);
        }
        SEAM(p0 + 10);
    }
    if (IN(PH_FINAL)) { PHASE_FRAME(); norm_rows<2>(F, out, out, KARG_IN(kp, I_GFINAL), nullptr); }
#if TSPROBE
    TS_END(PH_FINAL); xcd_barrier(bar);
    {
        float tail_tot = 0.f, bar_tot = 0.f, tail_sel = 0.f, span_sel = 0.f;
        for (int k = 0; k <= PH_FINAL; ++k) {
            const unsigned mx = __hip_atomic_load(TSW + k, RLX_AGENT), mb = ~__hip_atomic_load(TSW + 32 + k, RLX_AGENT), sb = __hip_atomic_load(TSW + 64 + k, RLX_AGENT);
            const float span = (float)(mx - mb) * 0.01f, busy = (float)sb * 0.01f / (float)F.G;
            tail_tot += span - busy;
            if (k < PH_FINAL) { const unsigned nb = ~__hip_atomic_load(TSW + 32 + k + 1, RLX_AGENT); bar_tot += (float)(int)(nb - mx) * 0.01f; }
            { const int ks = ((TSSEL) > 20 ? (TSSEL) - 21 : (TSSEL) - 1); if (k == ks || (ks < NPH && k == ks + NPH)) { tail_sel += span - busy; span_sel += span; } }
        }
        float stat;
        if (TSSEL == 0) stat = tail_tot; else if (TSSEL == 100) stat = bar_tot; else if (TSSEL <= 20) stat = tail_sel; else stat = span_sel;
        if (F.bid == 0 && F.tid == 0) { const unsigned long long t_end = __builtin_amdgcn_s_memrealtime() + (unsigned long long)(fmaxf(stat, 0.f) * (float)(TSMUL) * 100.0f);
            while (__builtin_amdgcn_s_memrealtime() < t_end) __builtin_amdgcn_s_sleep(8); }
    }
#endif
#undef IN
#undef SEAM
#undef out
#undef XN
#undef PA
#undef PC
#undef PD
#undef PB
#undef GT
#undef QB
#undef KVB
#undef KC
#undef KPE
#undef OA3
#undef LSE
#undef OCAT
#undef ROPE
}
static_assert(offsetof(Args, out) == 152 && offsetof(Args, ws) == 160 && offsetof(Args, ph_lo) == 168 && offsetof(Args, ph_hi) == 172, "KARG_* offsets");

extern "C" void kernel_launch(void* const* d_in, const int* in_sizes, int n_in, void* d_out, int out_size, void* d_ws, size_t ws_size, hipStream_t stream) {
    static int grid = 0;
    if (grid == 0) {
        if (n_in != 19 || out_size != T * DM || ws_size < WS_END) { fprintf(stderr, "kernel_launch: unexpected problem (n_in %d out %d ws %zu need %zu)\n", n_in, out_size, ws_size, (size_t)WS_END); grid = -1; return; }
        int dev = 0, cus = 0, per_cu = 0;
        if (hipGetDevice(&dev) != hipSuccess || hipDeviceGetAttribute(&cus, hipDeviceAttributeMultiprocessorCount, dev) != hipSuccess) { grid = -1; return; }
        if (hipFuncSetAttribute((const void*)fwd_kernel, hipFuncAttributeMaxDynamicSharedMemorySize, LDS_BYTES) != hipSuccess) { fprintf(stderr, "kernel_launch: hipFuncSetAttribute failed\n"); grid = -1; return; }
        if (hipOccupancyMaxActiveBlocksPerMultiprocessor(&per_cu, (const void*)fwd_kernel, NTHR, LDS_BYTES) != hipSuccess || per_cu < 1) fprintf(stderr, "kernel_launch: occupancy query reports %d\n", per_cu);
        (void)hipGetLastError();
        grid = cus;
    }
    if (grid < 0) return;
    (void)hipMemsetAsync((char*)d_ws + WS_CTL, 0, CTL_ZERO_BYTES, stream);
    Args a{};
    for (int i = 0; i < 19; ++i) a.in[i] = (const float*)d_in[i];
    a.out = (float*)d_out; a.ws = (unsigned char*)d_ws;
#if MK_PER_PHASE
    for (int p = 0; p < N_PHASES; ++p) { a.ph_lo = p; a.ph_hi = p + 1; hipLaunchKernelGGL(fwd_kernel, dim3(grid), dim3(NTHR), LDS_BYTES, stream, a); }
#else
    a.ph_lo = 0; a.ph_hi = N_PHASES; hipLaunchKernelGGL(fwd_kernel, dim3(grid), dim3(NTHR), LDS_BYTES, stream, a);
#endif
}
```
